# Optimizing an MI355X kernel written in HIP

```python
import jax, jax.numpy as jnp
from jax import lax
import numpy as np

D_MODEL = 2048
BATCH = 8
SEQ = 2048
DEPTH = 1

GRID_W = 64
ROPE_THETA = 10000.0
Q_BLOCK = 128
RMS_EPS = 1e-6

MLA_HEADS = 8
MLA_Q_RANK = 512
MLA_KV_RANK = 256
MLA_NOPE_DIM = 128
MLA_ROPE_DIM = 64
MLA_V_DIM = 128

GQA_HEADS = 8
GQA_KV_HEADS = 2
GQA_HEAD_DIM = 128
GQA_GROUP = GQA_HEADS // GQA_KV_HEADS

N_EXPERTS = 16
EC_CAPACITY = 2
EXPERT_FF = 1024

IN_WIDTHS = (
    MLA_Q_RANK,
    MLA_KV_RANK,
    MLA_ROPE_DIM,
    GQA_HEADS * GQA_HEAD_DIM,
    GQA_KV_HEADS * GQA_HEAD_DIM,
    GQA_KV_HEADS * GQA_HEAD_DIM,
    D_MODEL,
    D_MODEL,
)
IN_COLS = sum(IN_WIDTHS)
IN_SPLITS = tuple(int(s) for s in np.cumsum(IN_WIDTHS)[:-1])

kernel_name = "hybrid_mla_gqa_axial_ec_moe_encoder"


def _rmsnorm(x, g):
    xf = x.astype(jnp.float32)
    y = xf * lax.rsqrt(jnp.mean(xf * xf, axis=-1, keepdims=True) + RMS_EPS)
    return (y * g.astype(jnp.float32)).astype(x.dtype)


def _rope_angles(pos, dim):
    half = dim // 2
    freqs = ROPE_THETA ** (-jnp.arange(half, dtype=jnp.float32) / half)
    return pos.astype(jnp.float32)[:, None] * freqs[None, :]


def _rope(x, ang):
    cos = jnp.cos(ang).astype(x.dtype)
    sin = jnp.sin(ang).astype(x.dtype)
    x1, x2 = jnp.split(x, 2, axis=-1)
    return jnp.concatenate([x1 * cos - x2 * sin, x1 * sin + x2 * cos], axis=-1)


def _axial_rope(x, ang_row, ang_col):
    xr, xc = jnp.split(x, 2, axis=-1)
    return jnp.concatenate([_rope(xr, ang_row), _rope(xc, ang_col)], axis=-1)


def _query_blocks(q):
    *lead, s, d = q.shape
    qb = q.reshape(*lead, s // Q_BLOCK, Q_BLOCK, d)
    return jnp.moveaxis(qb, -3, 0)


def _merge_blocks(ob):
    ob = jnp.moveaxis(ob, 0, -3)
    return ob.reshape(*ob.shape[:-3], -1, ob.shape[-1])


def _mla_attention(qn, qr, kn, kr, v):
    scale = (MLA_NOPE_DIM + MLA_ROPE_DIM) ** -0.5

    def block(args):
        qn_b, qr_b = args
        s = (jnp.einsum('bhqd,bhkd->bhqk', qn_b, kn, preferred_element_type=jnp.float32)
             + jnp.einsum('bhqr,bkr->bhqk', qr_b, kr, preferred_element_type=jnp.float32)) * scale
        p = jax.nn.softmax(s, axis=-1).astype(v.dtype)
        return jnp.einsum('bhqk,bhkd->bhqd', p, v)

    return _merge_blocks(lax.map(block, (_query_blocks(qn), _query_blocks(qr))))


def _gqa_attention(q, k, v):
    scale = GQA_HEAD_DIM ** -0.5

    def block(q_b):
        s = jnp.einsum('bngqd,bnkd->bngqk', q_b, k, preferred_element_type=jnp.float32) * scale
        p = jax.nn.softmax(s, axis=-1).astype(v.dtype)
        return jnp.einsum('bngqk,bnkd->bngqd', p, v)

    return _merge_blocks(lax.map(block, _query_blocks(q)))


def _expert_choice_ffn(h, w_router, w_e_gate, w_e_up, w_e_down):
    b, s, d = h.shape
    cap = EC_CAPACITY * s // N_EXPERTS
    logits = jnp.einsum('bsd,de->bse', h, w_router, preferred_element_type=jnp.float32)
    aff = jax.nn.softmax(logits, axis=-1)
    vals, idx = lax.top_k(jnp.swapaxes(aff, 1, 2), cap)
    xg = jax.vmap(lambda hb, ib: hb[ib])(h, idx)
    a = jnp.einsum('becd,edf->becf', xg, w_e_gate)
    u = jnp.einsum('becd,edf->becf', xg, w_e_up)
    y = jnp.einsum('becf,efd->becd', jax.nn.silu(a) * u, w_e_down)
    y = y * vals.astype(y.dtype)[..., None]
    return jax.vmap(lambda ib, yb: jnp.zeros((s, d), yb.dtype).at[ib.reshape(-1)].add(yb.reshape(-1, d)))(idx, y)


def _layer(x, c, w_ada, b_ada, g_mix, w_in, g_cq, g_ckv, w_uq, w_ukv, g_qn, g_kn,
           w_br_a, w_br_b, w_out, g_ffn, w_router, w_e_gate, w_e_up, w_e_down,
           ang_1d, ang_row, ang_col):
    b, s, d = x.shape
    mod = jnp.einsum('bd,de->be', jax.nn.silu(c), w_ada) + b_ada
    sh1, sc1, gt1, sh2, sc2, gt2 = jnp.split(mod[:, None, :], 6, axis=-1)

    h = _rmsnorm(x, g_mix) * (1 + sc1) + sh1
    z = h @ w_in
    cq, ckv, kr, qg, kg, vg, gate_a, gate_b = jnp.split(z, IN_SPLITS, axis=-1)

    q = (_rmsnorm(cq, g_cq) @ w_uq).reshape(b, s, MLA_HEADS, MLA_NOPE_DIM + MLA_ROPE_DIM)
    q = q.transpose(0, 2, 1, 3)
    qn, qr = q[..., :MLA_NOPE_DIM], _rope(q[..., MLA_NOPE_DIM:], ang_1d)
    kv = (_rmsnorm(ckv, g_ckv) @ w_ukv).reshape(b, s, MLA_HEADS, MLA_NOPE_DIM + MLA_V_DIM)
    kv = kv.transpose(0, 2, 1, 3)
    kn, va = kv[..., :MLA_NOPE_DIM], kv[..., MLA_NOPE_DIM:]
    kr = _rope(kr, ang_1d)
    o_a = _mla_attention(qn, qr, kn, kr, va)
    o_a = o_a.transpose(0, 2, 1, 3).reshape(b, s, MLA_HEADS * MLA_V_DIM)

    qb = _rmsnorm(qg.reshape(b, s, GQA_HEADS, GQA_HEAD_DIM), g_qn).transpose(0, 2, 1, 3)
    kb = _rmsnorm(kg.reshape(b, s, GQA_KV_HEADS, GQA_HEAD_DIM), g_kn).transpose(0, 2, 1, 3)
    vb = vg.reshape(b, s, GQA_KV_HEADS, GQA_HEAD_DIM).transpose(0, 2, 1, 3)
    qb = _axial_rope(qb, ang_row, ang_col).reshape(b, GQA_KV_HEADS, GQA_GROUP, s, GQA_HEAD_DIM)
    kb = _axial_rope(kb, ang_row, ang_col)
    o_b = _gqa_attention(qb, kb, vb).reshape(b, GQA_HEADS, s, GQA_HEAD_DIM)
    o_b = o_b.transpose(0, 2, 1, 3).reshape(b, s, GQA_HEADS * GQA_HEAD_DIM)

    merged = jax.nn.sigmoid(gate_a) * (o_a @ w_br_a) + jax.nn.sigmoid(gate_b) * (o_b @ w_br_b)
    x = x + gt1 * (merged @ w_out)

    h2 = _rmsnorm(x, g_ffn) * (1 + sc2) + sh2
    x = x + gt2 * _expert_choice_ffn(h2, w_router, w_e_gate, w_e_up, w_e_down)
    return x


def setup_inputs(seed: int = 0) -> dict:
    key = jax.random.key(seed)
    ks = jax.random.split(key, 24)
    f32 = jnp.float32
    L = DEPTH

    def w(k, shape, fan_in):
        return jax.random.normal(k, shape, f32) * (fan_in ** -0.5)

    def gain(k, shape):
        return 1.0 + 0.02 * jax.random.normal(k, shape, f32)

    return {
        "x": jax.random.normal(ks[0], (BATCH, SEQ, D_MODEL), f32),
        "c": jax.random.normal(ks[1], (BATCH, D_MODEL), f32),
        "w_ada": w(ks[2], (L, D_MODEL, 6 * D_MODEL), D_MODEL),
        "b_ada": 0.02 * jax.random.normal(ks[3], (L, 6 * D_MODEL), f32),
        "g_mix": gain(ks[4], (L, D_MODEL)),
        "w_in": w(ks[5], (L, D_MODEL, IN_COLS), D_MODEL),
        "g_cq": gain(ks[6], (L, MLA_Q_RANK)),
        "g_ckv": gain(ks[7], (L, MLA_KV_RANK)),
        "w_uq": w(ks[8], (L, MLA_Q_RANK, MLA_HEADS * (MLA_NOPE_DIM + MLA_ROPE_DIM)), MLA_Q_RANK),
        "w_ukv": w(ks[9], (L, MLA_KV_RANK, MLA_HEADS * (MLA_NOPE_DIM + MLA_V_DIM)), MLA_KV_RANK),
        "g_qn": gain(ks[10], (L, GQA_HEAD_DIM)),
        "g_kn": gain(ks[11], (L, GQA_HEAD_DIM)),
        "w_br_a": w(ks[12], (L, MLA_HEADS * MLA_V_DIM, D_MODEL), MLA_HEADS * MLA_V_DIM),
        "w_br_b": w(ks[13], (L, GQA_HEADS * GQA_HEAD_DIM, D_MODEL), GQA_HEADS * GQA_HEAD_DIM),
        "w_out": w(ks[14], (L, D_MODEL, D_MODEL), D_MODEL),
        "g_ffn": gain(ks[15], (L, D_MODEL)),
        "w_router": w(ks[16], (L, D_MODEL, N_EXPERTS), D_MODEL),
        "w_e_gate": w(ks[17], (L, N_EXPERTS, D_MODEL, EXPERT_FF), D_MODEL),
        "w_e_up": w(ks[18], (L, N_EXPERTS, D_MODEL, EXPERT_FF), D_MODEL),
        "w_e_down": w(ks[19], (L, N_EXPERTS, EXPERT_FF, D_MODEL), EXPERT_FF),
        "g_final": gain(ks[20], (D_MODEL,)),
    }


def reference(x, c, w_ada, b_ada, g_mix, w_in, g_cq, g_ckv, w_uq, w_ukv, g_qn, g_kn,
              w_br_a, w_br_b, w_out, g_ffn, w_router, w_e_gate, w_e_up, w_e_down, g_final):
    s = x.shape[1]
    rows = s // GRID_W
    t = jnp.arange(s)
    row = jnp.repeat(jnp.arange(rows), GRID_W)
    col = jnp.tile(jnp.arange(GRID_W), rows)
    ang_1d = _rope_angles(t, MLA_ROPE_DIM)
    ang_row = _rope_angles(row, GQA_HEAD_DIM // 2)
    ang_col = _rope_angles(col, GQA_HEAD_DIM // 2)
    for l in range(DEPTH):
        x = _layer(x, c, w_ada[l], b_ada[l], g_mix[l], w_in[l], g_cq[l], g_ckv[l], w_uq[l],
                   w_ukv[l], g_qn[l], g_kn[l], w_br_a[l], w_br_b[l], w_out[l], g_ffn[l],
                   w_router[l], w_e_gate[l], w_e_up[l], w_e_down[l], ang_1d, ang_row, ang_col)
    return _rmsnorm(x, g_final)
```

```cpp
#include <hip/hip_runtime.h>
#include <stdint.h>
#include <cstdio>

constexpr int NB = 8, S = 2048, D = 2048, M = NB * S;
constexpr int NE = 16, CAP = 256, FF = 1024, NPAIR = NB * NE;
constexpr int IN_COLS = 6464;
constexpr int C_CQ = 0, C_CKV = 512, C_KR = 768, C_QG = 832, C_KG = 1856, C_VG = 2112, C_GA = 2368, C_GB = 4416;
constexpr float EPS = 1e-6f;
constexpr float LOG2E = 1.4426950408889634f;
constexpr float C2A = 0.07216878364870322f * LOG2E;
constexpr float C2B = 0.08838834764831845f * LOG2E;

typedef unsigned short bf16_t;
typedef float f32x4 __attribute__((ext_vector_type(4)));
typedef unsigned u32x4 __attribute__((ext_vector_type(4)));
typedef unsigned u32x2 __attribute__((ext_vector_type(2)));

__device__ __forceinline__ unsigned f2bf(float f) { unsigned u = __builtin_bit_cast(unsigned, f); return (u + 0x7fffu + ((u >> 16) & 1u)) >> 16; }
__device__ __forceinline__ unsigned pk2(float lo, float hi) { return f2bf(lo) | (f2bf(hi) << 16); }
__device__ __forceinline__ float bf2f(unsigned h) { return __builtin_bit_cast(float, h << 16); }
__device__ __forceinline__ float bflo(unsigned w) { return __builtin_bit_cast(float, w << 16); }
__device__ __forceinline__ float bfhi(unsigned w) { return __builtin_bit_cast(float, w & 0xffff0000u); }
__device__ __forceinline__ float wave_sum(float v) {
#pragma unroll
    for (int o = 1; o < 64; o <<= 1) v += __shfl_xor(v, o);
    return v;
}
__device__ __forceinline__ float wave_max(float v) {
#pragma unroll
    for (int o = 1; o < 64; o <<= 1) v = fmaxf(v, __shfl_xor(v, o));
    return v;
}

constexpr size_t MB = 1000000;
constexpr size_t al(size_t x) { return (x + 4095) / 4096 * 4096; }
constexpr size_t WS_CTL   = 0;
constexpr size_t WS_MOD   = 1u << 20;
constexpr size_t WS_TAB   = WS_MOD + al((size_t)NB * 6 * D * 4);
constexpr size_t WS_GP    = WS_TAB + al((size_t)2048 * 64 * 4);
constexpr size_t WS_SSQCQ = WS_GP + 4096;
constexpr size_t WS_SSQKV = WS_SSQCQ + al((size_t)M * 8 * 4);
constexpr size_t WS_SSQX1 = WS_SSQKV + al((size_t)M * 4 * 4);
constexpr size_t WS_AFF   = WS_SSQX1 + al((size_t)M * 32 * 4);
constexpr size_t WS_IDX   = WS_AFF + al((size_t)NPAIR * S * 4);
constexpr size_t WS_VAL   = WS_IDX + al((size_t)NPAIR * CAP * 4);
constexpr size_t WS_RANK  = WS_VAL + al((size_t)NPAIR * CAP * 4);
constexpr size_t WS_R1    = WS_RANK + al((size_t)M * 16 * 4);
constexpr size_t WS_R2    = WS_R1 + (size_t)M * D * 2;
constexpr size_t WS_R3    = WS_R2 + (size_t)M * D * 2;
constexpr size_t WS_CQ    = WS_R3 + (size_t)M * D * 2;
constexpr size_t WS_CKV   = WS_CQ + (size_t)M * 512 * 2;
constexpr size_t WS_KR    = WS_CKV + (size_t)M * 256 * 2;
constexpr size_t WS_QG    = WS_KR + (size_t)M * 64 * 2;
constexpr size_t WS_KG    = WS_QG + (size_t)M * 1024 * 2;
constexpr size_t WS_VG    = WS_KG + (size_t)M * 256 * 2;
constexpr size_t WS_QA    = WS_VG + (size_t)M * 256 * 2;
constexpr size_t WS_KVA   = WS_QA + (size_t)M * 1536 * 2;
constexpr size_t WS_OA    = WS_KVA + (size_t)M * 2048 * 2;
constexpr size_t WS_OB    = WS_OA + (size_t)M * 1024 * 2;
constexpr size_t WS_Y     = WS_CQ;
constexpr size_t WS_END0  = WS_OB + (size_t)M * 1024 * 2;
static_assert(WS_Y + (size_t)NPAIR * CAP * D * 2 <= WS_OA, "Y overlay");
constexpr size_t WS_MRG8 = WS_QA;
constexpr size_t WS_XN = WS_R1, WS_H2 = WS_R1, WS_GA = WS_R2, WS_ACT = WS_R2, WS_GB = WS_R3, WS_X1 = WS_R3;

__device__ __forceinline__ void sincos_d(double a, double& s, double& c) {
    const double q = rint(a * 0.63661977236758134308);
    double r = fma(-q, 1.57079632679489655800e+00, a);
    r = fma(-q, 6.12323399573676603587e-17, r);
    const double r2 = r * r;
    double sp = -1.0 / 1307674368000.0;
    sp = fma(sp, r2, 1.0 / 6227020800.0);
    sp = fma(sp, r2, -1.0 / 39916800.0);
    sp = fma(sp, r2, 1.0 / 362880.0);
    sp = fma(sp, r2, -1.0 / 5040.0);
    sp = fma(sp, r2, 1.0 / 120.0);
    sp = fma(sp, r2, -1.0 / 6.0);
    sp = fma(sp, r2, 1.0);
    const double sr = sp * r;
    double cp = 1.0 / 20922789888000.0;
    cp = fma(cp, r2, -1.0 / 87178291200.0);
    cp = fma(cp, r2, 1.0 / 479001600.0);
    cp = fma(cp, r2, -1.0 / 3628800.0);
    cp = fma(cp, r2, 1.0 / 40320.0);
    cp = fma(cp, r2, -1.0 / 720.0);
    cp = fma(cp, r2, 1.0 / 24.0);
    cp = fma(cp, r2, -0.5);
    cp = fma(cp, r2, 1.0);
    const int n = ((int)q) & 3;
    s = (n == 0) ? sr : (n == 1) ? cp : (n == 2) ? -sr : -cp;
    c = (n == 0) ? cp : (n == 1) ? -sr : (n == 2) ? -cp : sr;
}
__device__ __forceinline__ int perm_old_dim(int p) { const int blk = p & 64, q = p & 63; return blk + ((q & 1) ? (q >> 1) + 32 : (q >> 1)); }

#define LAS __attribute__((address_space(3)))
#define GAS __attribute__((address_space(1)))
typedef short bf16x8 __attribute__((ext_vector_type(8)));
typedef short s16x4 __attribute__((ext_vector_type(4)));
typedef float f32x16 __attribute__((ext_vector_type(16)));
typedef float f32x2 __attribute__((ext_vector_type(2)));

constexpr int IN_PAD = 6656;
constexpr size_t WS_WIN  = WS_END0;
constexpr size_t WS_WUQ  = WS_WIN  + (size_t)IN_PAD * D * 2;
constexpr size_t WS_WUKV = WS_WUQ  + (size_t)1536 * 512 * 2;
constexpr size_t WS_WBRA = WS_WUKV + (size_t)2048 * 256 * 2;
constexpr size_t WS_WBRB = WS_WBRA + (size_t)2048 * 1024 * 2;
constexpr size_t WS_WOUT = WS_WBRB + (size_t)2048 * 1024 * 2;
constexpr size_t WS_WGU  = WS_WOUT + (size_t)2048 * 2048 * 2;
constexpr size_t WS_WDN  = WS_WGU  + (size_t)NE * 2048 * 2048 * 2;
constexpr size_t WS_END  = WS_WDN  + (size_t)NE * 2048 * 1024 * 2;
constexpr size_t WS_MODP = WS_OA;
constexpr int MOD_SPLIT = 32;
static_assert((size_t)MOD_SPLIT * NB * 6 * D * 4 <= (size_t)M * 1024 * 2, "modp fits in OA");
static_assert(WS_END <= 729559040ull, "workspace budget");

constexpr int NWAVES = 8, NTHR = 512;
constexpr int RING_BYTES = 131072, EXCH_OFF = 131072, EXCH_BYTES = 8192, MISC_OFF = 160768  , LDS_BYTES = MISC_OFF + 256;
constexpr int CW_BAR = 256;
constexpr size_t CTL_ZERO_BYTES = 16384;

typedef __bf16 bf16x2_t __attribute__((ext_vector_type(2)));
__device__ __forceinline__ unsigned cvt_pk_bf16(float lo, float hi) { f32x2 v = {lo, hi}; bf16x2_t b = __builtin_convertvector(v, bf16x2_t); return __builtin_bit_cast(unsigned, b); }
__device__ __forceinline__ u32x4 pack8(f32x4 a, f32x4 b) { u32x4 w; w.x = cvt_pk_bf16(a.x, a.y); w.y = cvt_pk_bf16(a.z, a.w); w.z = cvt_pk_bf16(b.x, b.y); w.w = cvt_pk_bf16(b.z, b.w); return w; }
constexpr float QS = 16.f;
constexpr size_t WS_VTG = WS_VG;
constexpr size_t WS_VTA = WS_R3 + (size_t)M * D;
__device__ __forceinline__ u32x2 pack8_fp8(f32x4 a, f32x4 b);
__device__ __forceinline__ int vpos(int kk) { return 32 * ((kk >> 2) & 1) + 4 * (kk >> 3) + (kk & 3); }
__device__ __forceinline__ unsigned quad_tr4(unsigned w, int a) {
    const unsigned x0 = (unsigned)__builtin_amdgcn_mov_dpp((int)w, 0x00, 0xf, 0xf, true), x1 = (unsigned)__builtin_amdgcn_mov_dpp((int)w, 0x55, 0xf, 0xf, true);
    const unsigned x2 = (unsigned)__builtin_amdgcn_mov_dpp((int)w, 0xaa, 0xf, 0xf, true), x3 = (unsigned)__builtin_amdgcn_mov_dpp((int)w, 0xff, 0xf, 0xf, true);
    const int sh = 8 * a;
    return ((x0 >> sh) & 0xffu) | (((x1 >> sh) & 0xffu) << 8) | (((x2 >> sh) & 0xffu) << 16) | (((x3 >> sh) & 0xffu) << 24); }
__device__ __forceinline__ unsigned char fp8_byte(float v) { return (unsigned char)(__builtin_amdgcn_cvt_pk_fp8_f32(v, v, 0, false) & 0xffu); }
constexpr float W8_SCALE = 64.f;
constexpr float Y_SCALE = 16.f;
__device__ __forceinline__ unsigned pk4_fp8(float a, float b, float c, float d) { unsigned w = __builtin_amdgcn_cvt_pk_fp8_f32(a, b, 0, false); return __builtin_amdgcn_cvt_pk_fp8_f32(c, d, w, true); }
__device__ __forceinline__ u32x2 pack8_fp8(f32x4 a, f32x4 b) { u32x2 w; w.x = pk4_fp8(a.x, a.y, a.z, a.w); w.y = pk4_fp8(b.x, b.y, b.z, b.w); return w; }
__device__ __forceinline__ unsigned pk4_u8(float a, float b, float c, float d) {
    unsigned r = __builtin_amdgcn_cvt_pk_u8_f32(__builtin_rintf(a * 255.f), 0, 0u); r = __builtin_amdgcn_cvt_pk_u8_f32(__builtin_rintf(b * 255.f), 1, r);
    r = __builtin_amdgcn_cvt_pk_u8_f32(__builtin_rintf(c * 255.f), 2, r); return __builtin_amdgcn_cvt_pk_u8_f32(__builtin_rintf(d * 255.f), 3, r); }
__device__ __forceinline__ float ub0(unsigned w) { return (float)(w & 0xffu); }
__device__ __forceinline__ float ub1(unsigned w) { return (float)((w >> 8) & 0xffu); }
__device__ __forceinline__ float ub2(unsigned w) { return (float)((w >> 16) & 0xffu); }
__device__ __forceinline__ float ub3(unsigned w) { return (float)(w >> 24); }
__device__ __forceinline__ float sigmoidf_fast(float v) { return __builtin_amdgcn_rcpf(1.f + __builtin_amdgcn_exp2f(-v * LOG2E)); }

#define XB_TMO      128
#define XB_XCNT(j)  (256  + 64 * (j))
#define XB_XSUB(j)  (1280 + 64 * (j))
#define XB_XGEN(j)  (2304 + 64 * (j))
#define XB_TOP      3328
#define XB_TOPGEN   3392
#define XCD_BAR_WORDS 3456
#define XB_SPIN_CAP (1u << 18)
__device__ __forceinline__ unsigned xb_ld(unsigned* p)              { return __hip_atomic_load(p, __ATOMIC_RELAXED, __HIP_MEMORY_SCOPE_AGENT); }
__device__ __forceinline__ unsigned xb_add(unsigned* p, unsigned v) { return __hip_atomic_fetch_add(p, v, __ATOMIC_RELAXED, __HIP_MEMORY_SCOPE_AGENT); }
__device__ __forceinline__ unsigned xb_xcc_id() { return (unsigned)__builtin_amdgcn_s_getreg((3 << 11) | 20) & 0xFu; }
#define XB_SPIN(cond, bar) do { unsigned _sp = 0; while (cond) { __builtin_amdgcn_s_sleep(1); \
    if ((++_sp & 255u) == 0u) { if (xb_ld(&(bar)[XB_TMO])) break; if (_sp > XB_SPIN_CAP) { atomicAdd(&(bar)[XB_TMO], 1u); break; } } } } while (0)
struct XcdBarrier { unsigned* bar; unsigned x; volatile LAS unsigned* st; };
__device__ __forceinline__ XcdBarrier xcd_barrier_post(unsigned* bar, volatile LAS unsigned* st) {
    XcdBarrier b; b.bar = bar; b.x = xb_xcc_id(); b.st = st;
    if (threadIdx.x == 0) (void)xb_add(&bar[XB_XCNT(b.x)], 1u);
    return b;
}
__device__ __forceinline__ void xcd_barrier_complete(unsigned* bar, unsigned x, unsigned& nloc, unsigned& nx) {
    const unsigned G = gridDim.x * gridDim.y * gridDim.z;
    unsigned sum, cnt, mine, sp = 0u;
    for (;;) {
        sum = 0u; cnt = 0u; mine = 0u;
#pragma unroll
        for (unsigned j = 0; j < 16; ++j) { const unsigned c = xb_ld(&bar[XB_XCNT(j)]); sum += c; cnt += (c > 0u) ? 1u : 0u; mine = (j == x) ? c : mine; }
        if (sum == G) break;
        __builtin_amdgcn_s_sleep(1);
        if ((++sp & 255u) == 0u) { if (xb_ld(&bar[XB_TMO])) break; if (sp > XB_SPIN_CAP) { atomicAdd(&bar[XB_TMO], 1u); break; } }
    }
    nloc = mine > 0u ? mine : 1u; nx = cnt > 0u ? cnt : 1u;
}
__device__ __forceinline__ void xcd_barrier(const XcdBarrier& b) {
    asm volatile("s_waitcnt vmcnt(0)" ::: "memory");
    __syncthreads();
    if (threadIdx.x == 0) {
        unsigned* bar = b.bar;
        __builtin_amdgcn_s_waitcnt(0);
        unsigned nloc = b.st[0], nx = b.st[1];
        if (nloc == 0u) { xcd_barrier_complete(bar, b.x, nloc, nx); b.st[0] = nloc; b.st[1] = nx; }
        const unsigned old = xb_add(&bar[XB_XSUB(b.x)], 1u);
        const unsigned gen = old / nloc;
        if (old + 1u == (gen + 1u) * nloc) {
            __builtin_amdgcn_fence(__ATOMIC_RELEASE, "agent");
            asm volatile("s_waitcnt vmcnt(0)" ::: "memory");
            const unsigned og = xb_add(&bar[XB_TOP], 1u);
            const unsigned tg = og / nx;
            if (og + 1u == (tg + 1u) * nx) xb_add(&bar[XB_TOPGEN], 1u);
            else XB_SPIN(xb_ld(&bar[XB_TOPGEN]) == tg, bar);
            __builtin_amdgcn_fence(__ATOMIC_ACQUIRE, "agent");
            xb_add(&bar[XB_XGEN(b.x)], 1u);
            asm volatile("s_waitcnt vmcnt(0)" ::: "memory");
        } else {
            XB_SPIN(xb_ld(&bar[XB_XGEN(b.x)]) == gen, bar);
            __builtin_amdgcn_fence(__ATOMIC_ACQUIRE, "agent");
            asm volatile("s_waitcnt vmcnt(0)" ::: "memory");
        }
    }
    __syncthreads();
}

namespace pg {
constexpr int BM = 256, BK = 64, HALF = 128, HTB = HALF * BK * 2, NXCD = 8, WGM = 8;
__device__ __forceinline__ int lds_byte(int r, int c) { const int st = (r >> 4) * 2 + (c >> 5), rr = r & 15, cc = c & 31, ob = rr * 64 + cc * 2; return st * 1024 + (ob ^ (((ob >> 9) & 1) << 5)); }
__device__ __forceinline__ void stage_rc(int b, int& R, int& C) { const int st = b / 1024, sb = b % 1024, swz = sb ^ (((sb >> 9) & 1) << 5); R = (st >> 1) * 16 + swz / 64; C = (st & 1) * 32 + (swz % 64) / 2; }
__device__ __forceinline__ int perm32(int rho) { const int n = rho >> 4, i = rho & 15; return 8 * (i >> 2) + 4 * n + (i & 3); }

struct Unit { const char* A; const char* B; int pm, pn, aux, pad; };
typedef int v8i __attribute__((ext_vector_type(8))); typedef int v4i __attribute__((ext_vector_type(4)));
__device__ __forceinline__ void mfma_f8(f32x4& c, const v8i w, const v8i x, const int scale_w, const int scale_x) {
    asm volatile("v_mfma_scale_f32_16x16x128_f8f6f4 %0, %1, %2, %0, %3, %4 op_sel_hi:[0,0,0]" : "+v"(c) : "v"(w), "v"(x), "v"(scale_w), "v"(scale_x)); }
__device__ __forceinline__ v8i cat8(bf16x8 lo, bf16x8 hi) { const v4i a = __builtin_bit_cast(v4i, lo), b = __builtin_bit_cast(v4i, hi); return __builtin_shufflevector(a, b, 0, 1, 2, 3, 4, 5, 6, 7); }
typedef f32x4 Acc[2][2][4][2];

struct GridSched {
    const char* A; const char* B; size_t at, bt; int nM, nN, nwg, G, c; int r0 = 0, r1 = 1 << 20;
    __device__ __forceinline__ void init(const void* A_, const void* B_, int lda, int K, int Mr, int N, int G_, int c_) {
        A = (const char*)A_; B = (const char*)B_; at = (size_t)BM * lda * 2; bt = (size_t)BM * K * 2; nM = Mr / BM; nN = N / BM; nwg = nM * nN; G = G_; c = c_; }
    __device__ __forceinline__ void tile(long L, int& pm, int& pn) const {
        int wgid = (int)L; { const int q = nwg / NXCD, r = nwg % NXCD, xcd = wgid % NXCD, off = wgid / NXCD; wgid = (xcd < r ? xcd * (q + 1) : r * (q + 1) + (xcd - r) * q) + off; }
        const int nig = WGM * nN, gid = wgid / nig, fm = gid * WGM, gsz = (nM - fm) < WGM ? (nM - fm) : WGM;
        pm = fm + ((wgid % nig) % gsz); pn = (wgid % nig) / gsz; }
    __device__ __forceinline__ bool next(int i, Unit& u) const {
        if (i + r0 >= r1) return false;
        const long L = (long)(i + r0) * G + c; if (L >= nwg) return false;
        tile(L, u.pm, u.pn); u.A = A + (size_t)u.pm * at; u.B = B + (size_t)u.pn * bt; u.aux = 0; return true; }
};
struct ListSched {
    const char* A; const char* B; size_t at, bt; int nN, first, stride, count;
    __device__ __forceinline__ bool next(int i, Unit& u) const {
        if (i >= count) return false; const int t = first + i * stride; u.pm = t / nN; u.pn = t - u.pm * nN;
        u.A = A + (size_t)u.pm * at; u.B = B + (size_t)u.pn * bt; u.aux = 0; return true; }
};
struct PairSched {
    GridSched g; const char* A1; const char* B1;
    __device__ __forceinline__ bool next(int i, Unit& u) const {
        const long L = (long)(i >> 1) * g.G + g.c; if (L >= g.nwg) return false;
        g.tile(L, u.pm, u.pn); const int w = i & 1;
        u.A = (w ? A1 : g.A) + (size_t)u.pm * g.at; u.B = (w ? B1 : g.B) + (size_t)u.pn * g.bt; u.aux = w; return true; }
};
struct MoeSched {
    const char* A; const char* B; size_t a_pair, b_exp, b_tile; int G, c; bool gather;
    __device__ __forceinline__ bool next(int i, Unit& u) const {
        const long L = (long)i * G + c; if (L >= NPAIR * 8) return false;
        const int x = (int)(L & 7), q = (int)(L >> 3), e = 2 * x + (q >> 6), r = q & 63, b = r >> 3, nt = r & 7;
        u.pm = b * NE + e; u.pn = nt; u.aux = b * NE + e;
        u.A = A + (gather ? (size_t)b * a_pair : (size_t)u.pm * a_pair); u.B = B + (size_t)e * b_exp + (size_t)nt * b_tile; return true; }
};

template <class Epi, class Sched, bool GATHER, bool F8 = false>
__device__ __forceinline__ void gemm_phase(LAS unsigned char* lds, const int K, const int lda, const Sched& S, const Epi& E, const int* __restrict__ gidx) {
    const int tid = threadIdx.x, wid = __builtin_amdgcn_readfirstlane(tid >> 6), lane = tid & 63, wr = wid >> 2, wc = wid & 3, fr = lane & 15, fq = lane >> 4;
    int nt_ = K / BK; asm volatile("" : "+s"(nt_)); const int nt = nt_;
    unsigned voffA[2], voffB[2]; int RA[2], CA2[2];
#pragma unroll
    for (int i = 0; i < 2; ++i) { int R, C; stage_rc(tid * 16 + i * 8192, R, C); const int Rb = Epi::PERM ? ((R & ~31) + perm32(R & 31)) : R;
        RA[i] = R; CA2[i] = C * 2; voffA[i] = (unsigned)(R * lda + C) * 2u; voffB[i] = (unsigned)(Rb * K + C) * 2u; }
    const size_t kstep = (size_t)(BK * 2);
    const size_t hstepA = GATHER ? 0 : (size_t)HALF * lda * 2, hstepB = (size_t)HALF * K * 2;
    const unsigned ldsw = (unsigned)wid * 1024u;
    const int aoff = lds_byte(wr * 64 + fr, fq * 8), boff = lds_byte(wc * 32 + fr, fq * 8);
    unsigned vAc[2][2], vAn[2][2];
    int sc1 = 0x7F7F7F7F, scw = 0x79797979; asm volatile("" : "+v"(sc1), "+v"(scw));
#define PG_SA(b, h) (((b) * 2 + (h)) * HTB)
#define PG_SB(b, h) ((4 + (b) * 2 + (h)) * HTB)
#define PG_GLDS(bufoff, gp, v0, v1) do { \
        __builtin_amdgcn_global_load_lds((const unsigned*)((gp) + (v0)), (LAS unsigned*)(lds + (bufoff) + ldsw), 16, 0, 0); \
        __builtin_amdgcn_global_load_lds((const unsigned*)((gp) + (v1)), (LAS unsigned*)(lds + (bufoff) + ldsw + 8192), 16, 0, 0); } while (0)
#define PG_STAGE_B(bufoff, gp) PG_GLDS(bufoff, gp, voffB[0], voffB[1])
#define PG_STAGE_A(bufoff, gp, h, usen) do { if constexpr (GATHER) { const unsigned _v0 = (usen) ? vAn[h][0] : vAc[h][0], _v1 = (usen) ? vAn[h][1] : vAc[h][1]; PG_GLDS(bufoff, gp, _v0, _v1); } \
        else { PG_GLDS(bufoff, (gp) + (h) * hstepA, voffA[0], voffA[1]); } } while (0)
#define PG_LDA(dst, b, h) do { _Pragma("unroll") for (int m = 0; m < 4; ++m) _Pragma("unroll") for (int k = 0; k < 2; ++k) dst[m][k] = *(const LAS bf16x8*)(lds + PG_SA(b, h) + aoff + m * 2048 + k * 1024); } while (0)
#define PG_LDB(dst, b, h) do { _Pragma("unroll") for (int n = 0; n < 2; ++n) _Pragma("unroll") for (int k = 0; k < 2; ++k) dst[n][k] = *(const LAS bf16x8*)(lds + PG_SB(b, h) + boff + n * 2048 + k * 1024); } while (0)
#define PG_MMA(ai, bj, At, Bt) do { __builtin_amdgcn_s_setprio(1); _Pragma("unroll") for (int m = 0; m < 4; ++m) _Pragma("unroll") for (int n = 0; n < 2; ++n) { \
        if constexpr (F8) mfma_f8(acc[ai][bj][m][n], cat8(Bt[n][0], Bt[n][1]), cat8(At[m][0], At[m][1]), scw, sc1); \
        else { _Pragma("unroll") for (int k = 0; k < 2; ++k) acc[ai][bj][m][n] = __builtin_amdgcn_mfma_f32_16x16x32_bf16(Bt[n][k], At[m][k], acc[ai][bj][m][n], 0, 0, 0); } } \
        __builtin_amdgcn_s_setprio(0); } while (0)
#ifdef DRAIN_ALL
#define PG_WAIT_V(n) asm volatile("s_waitcnt vmcnt(0)" ::: "memory")
#else
#define PG_WAIT_V(n) asm volatile("s_waitcnt vmcnt(" #n ")" ::: "memory")
#endif
#define PG_WAIT_L(n) asm volatile("s_waitcnt lgkmcnt(" #n ")" ::: "memory")
#define PG_BAR __builtin_amdgcn_s_barrier()
#define PG_SCHED __builtin_amdgcn_sched_barrier(0)
    Unit cur, nxt; int ui = 0;
    if (!S.next(0, cur)) return;
    if constexpr (GATHER) {
#pragma unroll
        for (int h = 0; h < 2; ++h)
#pragma unroll
            for (int i = 0; i < 2; ++i) vAc[h][i] = (unsigned)(gidx[cur.aux * CAP + h * HALF + RA[i]] * lda * 2 + CA2[i]);
    }
    Acc acc;
#pragma unroll
    for (int a = 0; a < 2; ++a)
#pragma unroll
        for (int b = 0; b < 2; ++b)
#pragma unroll
            for (int m = 0; m < 4; ++m)
#pragma unroll
                for (int n = 0; n < 2; ++n) acc[a][b][m][n] = (f32x4){0.f, 0.f, 0.f, 0.f};
    bf16x8 At[4][2], B0[2][2], B1[2][2];
    const char* cA = cur.A; const char* cB = cur.B;
    PG_STAGE_B(PG_SB(0, 0), cB); PG_STAGE_B(PG_SB(0, 1), cB + hstepB); PG_STAGE_A(PG_SA(0, 0), cA, 0, false); PG_STAGE_A(PG_SA(0, 1), cA, 1, false);
    if (wr == 1) PG_BAR;
    PG_WAIT_V(2); PG_BAR;
    PG_STAGE_B(PG_SB(1, 0), cB + kstep); PG_STAGE_A(PG_SA(1, 0), cA + kstep, 0, false); PG_STAGE_B(PG_SB(1, 1), cB + hstepB + kstep);
    PG_WAIT_V(6); PG_BAR;
    for (;;) {
        const bool has_next = S.next(ui + 1, nxt);
        if constexpr (GATHER) {
            if (has_next) {
#pragma unroll
                for (int h = 0; h < 2; ++h)
#pragma unroll
                    for (int i = 0; i < 2; ++i) vAn[h][i] = (unsigned)(gidx[nxt.aux * CAP + h * HALF + RA[i]] * lda * 2 + CA2[i]);
            } else {
#pragma unroll
                for (int h = 0; h < 2; ++h)
#pragma unroll
                    for (int i = 0; i < 2; ++i) vAn[h][i] = vAc[h][i];
            }
        }
        const char* nA = has_next ? nxt.A : cA; const char* nB = has_next ? nxt.B : cB;
        for (int t = 0; t < nt; t += 2) {
            const bool last = (t == nt - 2);
            const char* a1 = cA + (size_t)(t + 1) * kstep;
            const char* a2 = last ? nA : cA + (size_t)(t + 2) * kstep; const char* b2 = last ? nB : cB + (size_t)(t + 2) * kstep;
            const char* a3 = a2 + kstep; const char* b3 = b2 + kstep;
            PG_LDB(B0, 0, 0); PG_LDB(B1, 0, 1); PG_SCHED; PG_LDA(At, 0, 0); PG_STAGE_A(PG_SA(1, 1), a1, 1, false);
            PG_WAIT_V(8); PG_WAIT_L(0); PG_BAR; PG_MMA(0, 0, At, B0); PG_MMA(0, 1, At, B1); PG_BAR; PG_SCHED;
            PG_LDA(At, 0, 1); PG_STAGE_B(PG_SB(0, 0), b2); PG_STAGE_B(PG_SB(0, 1), b2 + hstepB); PG_STAGE_A(PG_SA(0, 0), a2, 0, last);
            PG_WAIT_V(8); PG_WAIT_L(0); PG_BAR; PG_MMA(1, 0, At, B0); PG_MMA(1, 1, At, B1); PG_BAR; PG_SCHED;
            PG_LDB(B0, 1, 0); PG_LDB(B1, 1, 1); PG_SCHED; PG_LDA(At, 1, 0); PG_STAGE_A(PG_SA(0, 1), a2, 1, last);
            PG_WAIT_V(8); PG_WAIT_L(0); PG_BAR; PG_MMA(0, 0, At, B0); PG_MMA(0, 1, At, B1); PG_BAR; PG_SCHED;
            PG_LDA(At, 1, 1); PG_STAGE_B(PG_SB(1, 0), b3); PG_STAGE_B(PG_SB(1, 1), b3 + hstepB); PG_STAGE_A(PG_SA(1, 0), a3, 0, last);
            PG_WAIT_V(8); PG_WAIT_L(0); PG_BAR; PG_MMA(1, 0, At, B0); PG_MMA(1, 1, At, B1); PG_BAR; PG_SCHED;
        }
        if constexpr (F8) asm volatile("s_nop 15\n\ts_nop 7" ::: "memory");
        if (wr == 0) PG_BAR;
        E(acc, cur, wr, wc, fr, fq, lds);
        if (!has_next) break;
        if (!(Epi::KEEP && cur.aux == 0)) {
#pragma unroll
            for (int a = 0; a < 2; ++a)
#pragma unroll
                for (int b = 0; b < 2; ++b)
#pragma unroll
                    for (int m = 0; m < 4; ++m)
#pragma unroll
                        for (int n = 0; n < 2; ++n) acc[a][b][m][n] = (f32x4){0.f, 0.f, 0.f, 0.f};
        }
        cur = nxt; cA = nA; cB = nB; ++ui;
        if constexpr (GATHER) {
#pragma unroll
            for (int h = 0; h < 2; ++h)
#pragma unroll
                for (int i = 0; i < 2; ++i) vAc[h][i] = vAn[h][i];
        }
        if (wr == 1) PG_BAR;
    }
    PG_WAIT_V(0);
    PG_BAR;
#undef PG_SA
#undef PG_SB
#undef PG_GLDS
#undef PG_STAGE_A
#undef PG_STAGE_B
#undef PG_LDA
#undef PG_LDB
#undef PG_MMA
}

#define ST16(p, v) do { *(u32x4*)(p) = (v); } while (0)
__device__ __forceinline__ void rope8(f32x4& v0, f32x4& v1, const f32x4 cs0, const f32x4 cs1) {
    const f32x4 a = v0, b = v1;
    v0.x = a.x * cs0.x - a.y * cs0.y; v0.y = a.x * cs0.y + a.y * cs0.x; v0.z = a.z * cs0.z - a.w * cs0.w; v0.w = a.z * cs0.w + a.w * cs0.z;
    v1.x = b.x * cs1.x - b.y * cs1.y; v1.y = b.x * cs1.y + b.y * cs1.x; v1.z = b.z * cs1.z - b.w * cs1.w; v1.w = b.z * cs1.w + b.w * cs1.z;
}
__device__ __forceinline__ float dot8(f32x4 a, f32x4 b) { return (a.x * a.x + a.y * a.y) + (a.z * a.z + a.w * a.w) + (b.x * b.x + b.y * b.y) + (b.z * b.z + b.w * b.w); }

struct EpiIn {
    static constexpr bool PERM = true; static constexpr bool KEEP = false;
    bf16_t *CQ, *CKV; unsigned char *KR, *QG, *KG;
    unsigned char* VT; unsigned char *GA, *GB; float *ssq_cq, *ssq_kv; const float* tab; const float* gp;
    __device__ __forceinline__ void operator()(const Acc& acc, const Unit& u, int wr, int wc, int fr, int fq, LAS unsigned char* lds) const {
        int fro = fr; asm volatile("" : "+v"(fro)); int fqo = fq; asm volatile("" : "+v"(fqo));
        const int pn = u.pn, row0 = u.pm * BM + wr * 64 + fro, cw = wc * 32 + 8 * fq, cwo = wc * 32 + 8 * fqo;
        if (pn <= 2) {
            unsigned char* O = (unsigned char*)(pn < 2 ? CQ : CKV); const int ld = pn < 2 ? 512 : 256, c0 = pn < 2 ? pn * 256 : 0;
            float* sq = pn < 2 ? ssq_cq : ssq_kv; const int ns = pn < 2 ? 8 : 4, s0 = pn < 2 ? pn * 4 : 0;
#pragma unroll
            for (int ai = 0; ai < 2; ++ai)
#pragma unroll
                for (int m = 0; m < 4; ++m) { const int row = row0 + ai * HALF + m * 16; float s = 0.f;
#pragma unroll
                    for (int bj = 0; bj < 2; ++bj) { const f32x4 v0 = acc[ai][bj][m][0], v1 = acc[ai][bj][m][1]; s += dot8(v0, v1);
                        *(u32x2*)(O + (size_t)row * ld + c0 + bj * HALF + cwo) = pack8_fp8(v0, v1); }
                    s += __shfl_xor(s, 16); s += __shfl_xor(s, 32);
                    if (fqo == 0) sq[(size_t)row * ns + s0 + wc] = s; }
        } else if (pn == 3) {
            if (wc < 2) {
#pragma unroll
                for (int ai = 0; ai < 2; ++ai) { f32x4 cs[4][2];
#pragma unroll
                    for (int m = 0; m < 4; ++m) { const int s = (row0 + ai * HALF + m * 16) & (S - 1); const f32x4* tp = (const f32x4*)(tab + (size_t)(s * 32 + 16 * wc + 4 * fqo) * 2); cs[m][0] = tp[0]; cs[m][1] = tp[1]; }
#pragma unroll
                    for (int m = 0; m < 4; ++m) { const int row = row0 + ai * HALF + m * 16;
                        f32x4 v0 = acc[ai][0][m][0], v1 = acc[ai][0][m][1]; rope8(v0, v1, cs[m][0], cs[m][1]);
                        *(u32x2*)(KR + (size_t)row * 64 + cwo) = pack8_fp8(v0, v1); } }
            }
        } else if (pn <= 8) {
            const bool isk = (pn == 8);
            LAS float* X = (LAS float*)(lds + EXCH_OFF);
            const f32x4 g0 = *(const f32x4*)(gp + (isk ? 128 : 0) + cwo), g1 = *(const f32x4*)(gp + (isk ? 128 : 0) + cwo + 4);
#pragma unroll
            for (int ai = 0; ai < 2; ++ai)
#pragma unroll
                for (int m = 0; m < 4; ++m)
#pragma unroll
                    for (int bj = 0; bj < 2; ++bj) { float s = dot8(acc[ai][bj][m][0], acc[ai][bj][m][1]); s += __shfl_xor(s, 16); s += __shfl_xor(s, 32);
                        if (fqo == 0) X[((ai * HALF + wr * 64 + m * 16 + fro) * 2 + bj) * 4 + wc] = s; }
            asm volatile("s_waitcnt lgkmcnt(0)" ::: "memory"); __builtin_amdgcn_s_barrier(); asm volatile("" ::: "memory");
            const float scale = isk ? 1.0f : C2B * QS;
            unsigned char* O = isk ? KG : QG; const int ld = isk ? 256 : 1024, c0 = isk ? 0 : (pn - 4) * 256;
#pragma unroll
            for (int ai = 0; ai < 2; ++ai) { f32x4 cs[4][2];
#pragma unroll
                for (int m = 0; m < 4; ++m) { const int s = (row0 + ai * HALF + m * 16) & (S - 1), pos = (wc < 2) ? (s >> 6) : (s & 63);
                    const f32x4* tp = (const f32x4*)(tab + (size_t)(pos * 32 + 16 * (wc & 1) + 4 * fqo) * 2); cs[m][0] = tp[0]; cs[m][1] = tp[1]; }
#pragma unroll
                for (int m = 0; m < 4; ++m) { const int rl = ai * HALF + wr * 64 + m * 16 + fro, row = u.pm * BM + rl;
#pragma unroll
                    for (int bj = 0; bj < 2; ++bj) { const f32x4 pp = *(const LAS f32x4*)(X + (rl * 2 + bj) * 4);
                        const float rstd = rsqrtf(((pp.x + pp.y) + (pp.z + pp.w)) * (1.f / 128.f) + EPS) * scale;
                        f32x4 v0 = acc[ai][bj][m][0] * rstd * g0, v1 = acc[ai][bj][m][1] * rstd * g1; rope8(v0, v1, cs[m][0], cs[m][1]);
                        *(u32x2*)(O + (size_t)row * ld + c0 + bj * HALF + cwo) = pack8_fp8(v0, v1); } } }
        } else if (pn == 9) {
#pragma unroll
            for (int ai = 0; ai < 2; ++ai)
#pragma unroll
                for (int m = 0; m < 4; ++m) { const int row = row0 + ai * HALF + m * 16, b = row >> 11, sq = row & (S - 1), t = sq >> 6, kp = vpos(sq & 60);
#pragma unroll
                    for (int bj = 0; bj < 2; ++bj) { unsigned char* img = VT + ((size_t)((b * 2 + bj) * 32 + t) * 128 + cwo + (fro & 3)) * 64 + kp;
#pragma unroll
                        for (int n = 0; n < 2; ++n) { const f32x4 v = acc[ai][bj][m][n]; *(unsigned*)(img + 4 * n * 64) = quad_tr4(pk4_fp8(v.x, v.y, v.z, v.w), fro & 3); } } }
        } else {
            unsigned char* O = pn < 18 ? GA : GB; const int c0 = (pn < 18 ? pn - 10 : pn - 18) * 256;
#pragma unroll
            for (int ai = 0; ai < 2; ++ai)
#pragma unroll
                for (int m = 0; m < 4; ++m) { const int row = row0 + ai * HALF + m * 16;
#pragma unroll
                    for (int bj = 0; bj < 2; ++bj) { f32x4 v0 = acc[ai][bj][m][0], v1 = acc[ai][bj][m][1];
                        v0.x = sigmoidf_fast(v0.x); v0.y = sigmoidf_fast(v0.y); v0.z = sigmoidf_fast(v0.z); v0.w = sigmoidf_fast(v0.w);
                        v1.x = sigmoidf_fast(v1.x); v1.y = sigmoidf_fast(v1.y); v1.z = sigmoidf_fast(v1.z); v1.w = sigmoidf_fast(v1.w);
                        u32x2 w8; w8.x = pk4_u8(v0.x, v0.y, v0.z, v0.w); w8.y = pk4_u8(v1.x, v1.y, v1.z, v1.w);
                        *(u32x2*)(O + (size_t)row * D + c0 + bj * HALF + cwo) = w8; } }
        }
    }
};
struct EpiGate {
    static constexpr bool PERM = true; static constexpr bool KEEP = false;
    unsigned char* O; int c_sub;
    __device__ __forceinline__ void operator()(const Acc& acc, const Unit& u, int wr, int wc, int fr_, int fq_, LAS unsigned char*) const {
        int fr = fr_; asm volatile("" : "+v"(fr)); int fq = fq_; asm volatile("" : "+v"(fq));
        const int row0 = u.pm * BM + wr * 64 + fr, cw = wc * 32 + 8 * fq, c0 = (u.pn - c_sub) * 256;
#pragma unroll
        for (int ai = 0; ai < 2; ++ai)
#pragma unroll
            for (int m = 0; m < 4; ++m) { const int row = row0 + ai * HALF + m * 16;
#pragma unroll
                for (int bj = 0; bj < 2; ++bj) { f32x4 v0 = acc[ai][bj][m][0], v1 = acc[ai][bj][m][1];
                    v0.x = sigmoidf_fast(v0.x); v0.y = sigmoidf_fast(v0.y); v0.z = sigmoidf_fast(v0.z); v0.w = sigmoidf_fast(v0.w);
                    v1.x = sigmoidf_fast(v1.x); v1.y = sigmoidf_fast(v1.y); v1.z = sigmoidf_fast(v1.z); v1.w = sigmoidf_fast(v1.w);
                    u32x2 w8; w8.x = pk4_u8(v0.x, v0.y, v0.z, v0.w); w8.y = pk4_u8(v1.x, v1.y, v1.z, v1.w);
                    *(u32x2*)(O + (size_t)row * D + c0 + bj * HALF + cw) = w8; } }
    }
};
struct EpiUq {
    static constexpr bool PERM = true; static constexpr bool KEEP = false;
    unsigned char* QA; const float* ssq; const float* tab;
    __device__ __forceinline__ void operator()(const Acc& acc, const Unit& u, int wr, int wc, int fr, int fq, LAS unsigned char*) const {
        const int row0 = u.pm * BM + wr * 64 + fr;
#pragma unroll
        for (int ai = 0; ai < 2; ++ai) {
            f32x4 q0[4], q1[4], cs0[4], cs1[4];
#pragma unroll
            for (int m = 0; m < 4; ++m) { const int row = row0 + ai * HALF + m * 16, s = row & (S - 1);
                q0[m] = *(const f32x4*)(ssq + (size_t)row * 8); q1[m] = *(const f32x4*)(ssq + (size_t)row * 8 + 4);
                const f32x4* tp = (const f32x4*)(tab + (size_t)(s * 32 + 16 * (wc & 1) + 4 * fq) * 2); cs0[m] = tp[0]; cs1[m] = tp[1]; }
#pragma unroll
            for (int m = 0; m < 4; ++m) { const int row = row0 + ai * HALF + m * 16;
                const float rstd = rsqrtf((((q0[m].x + q0[m].y) + (q0[m].z + q0[m].w)) + ((q1[m].x + q1[m].y) + (q1[m].z + q1[m].w))) * (1.f / 512.f) + EPS) * (C2A * QS);
#pragma unroll
                for (int bj = 0; bj < 2; ++bj) { const int cg = u.pn * BM + bj * HALF + wc * 32; const bool rope = ((cg >> 6) % 3) == 2;
                    f32x4 v0 = acc[ai][bj][m][0] * rstd, v1 = acc[ai][bj][m][1] * rstd; if (rope) rope8(v0, v1, cs0[m], cs1[m]);
                    *(u32x2*)(QA + (size_t)row * 1536 + cg + 8 * fq) = pack8_fp8(v0, v1); } }
        }
    }
};
struct EpiUkv {
    static constexpr bool PERM = true; static constexpr bool KEEP = false;
    unsigned char* KA; const float* ssq; unsigned char* VT;
    __device__ __forceinline__ void operator()(const Acc& acc, const Unit& u, int wr, int wc, int fr, int fq, LAS unsigned char*) const {
        const int row0 = u.pm * BM + wr * 64 + fr, cw = wc * 32 + 8 * fq;
        f32x4 q0[2][4];
#pragma unroll
        for (int ai = 0; ai < 2; ++ai)
#pragma unroll
            for (int m = 0; m < 4; ++m) q0[ai][m] = *(const f32x4*)(ssq + (size_t)(row0 + ai * HALF + m * 16) * 4);
#pragma unroll
        for (int ai = 0; ai < 2; ++ai)
#pragma unroll
            for (int m = 0; m < 4; ++m) { const int row = row0 + ai * HALF + m * 16;
                const float rstd = rsqrtf(((q0[ai][m].x + q0[ai][m].y) + (q0[ai][m].z + q0[ai][m].w)) * (1.f / 256.f) + EPS);
                *(u32x2*)(KA + (size_t)row * 1024 + u.pn * HALF + cw) = pack8_fp8(acc[ai][0][m][0] * rstd, acc[ai][0][m][1] * rstd);
                const int b = row >> 11, sq = row & (S - 1);
                unsigned char* img = VT + ((size_t)((b * 8 + u.pn) * 32 + (sq >> 6)) * 128 + cw + (fr & 3)) * 64 + vpos(sq & 60);
#pragma unroll
                for (int n = 0; n < 2; ++n) { const f32x4 v = acc[ai][1][m][n] * rstd; *(unsigned*)(img + 4 * n * 64) = quad_tr4(pk4_fp8(v.x, v.y, v.z, v.w), fr & 3); } }
    }
};
__device__ __forceinline__ float gclamp(float g) { return fmaxf(g, 0.25f); }
__device__ __forceinline__ void ratio8(f32x4& v0, f32x4& v1, const u32x2 a, const u32x2 b) {
    v0.x *= ub0(a.x) * __builtin_amdgcn_rcpf(gclamp(ub0(b.x))); v0.y *= ub1(a.x) * __builtin_amdgcn_rcpf(gclamp(ub1(b.x)));
    v0.z *= ub2(a.x) * __builtin_amdgcn_rcpf(gclamp(ub2(b.x))); v0.w *= ub3(a.x) * __builtin_amdgcn_rcpf(gclamp(ub3(b.x)));
    v1.x *= ub0(a.y) * __builtin_amdgcn_rcpf(gclamp(ub0(b.y))); v1.y *= ub1(a.y) * __builtin_amdgcn_rcpf(gclamp(ub1(b.y)));
    v1.z *= ub2(a.y) * __builtin_amdgcn_rcpf(gclamp(ub2(b.y))); v1.w *= ub3(a.y) * __builtin_amdgcn_rcpf(gclamp(ub3(b.y))); }
__device__ __forceinline__ void gate8c(f32x4& v0, f32x4& v1, const u32x2 g) {
    constexpr float k = 1.f / 255.f;
    v0.x *= gclamp(ub0(g.x)) * k; v0.y *= gclamp(ub1(g.x)) * k; v0.z *= gclamp(ub2(g.x)) * k; v0.w *= gclamp(ub3(g.x)) * k;
    v1.x *= gclamp(ub0(g.y)) * k; v1.y *= gclamp(ub1(g.y)) * k; v1.z *= gclamp(ub2(g.y)) * k; v1.w *= gclamp(ub3(g.y)) * k; }
struct EpiBr {
    static constexpr bool PERM = true; static constexpr bool KEEP = true;
    unsigned char* MRG8; const unsigned char* GA; const unsigned char* GB;
    __device__ __forceinline__ void operator()(Acc& acc, const Unit& u, int wr, int wc, int fr, int fq, LAS unsigned char*) const {
        const int row0 = u.pm * BM + wr * 64 + fr, cw = wc * 32 + 8 * fq;
        const size_t off0 = (size_t)row0 * D + u.pn * BM + cw;
        if (u.aux == 0) {
            u32x2 g[2][4][2], h[2][4][2];
#pragma unroll
            for (int ai = 0; ai < 2; ++ai)
#pragma unroll
                for (int m = 0; m < 4; ++m)
#pragma unroll
                    for (int bj = 0; bj < 2; ++bj) { const size_t o = off0 + (size_t)(ai * HALF + m * 16) * D + bj * HALF; g[ai][m][bj] = *(const u32x2*)(GA + o); h[ai][m][bj] = *(const u32x2*)(GB + o); }
#pragma unroll
            for (int ai = 0; ai < 2; ++ai)
#pragma unroll
                for (int m = 0; m < 4; ++m)
#pragma unroll
                    for (int bj = 0; bj < 2; ++bj) ratio8(acc[ai][bj][m][0], acc[ai][bj][m][1], g[ai][m][bj], h[ai][m][bj]);
        } else {
            u32x2 g[2][4][2];
#pragma unroll
            for (int ai = 0; ai < 2; ++ai)
#pragma unroll
                for (int m = 0; m < 4; ++m)
#pragma unroll
                    for (int bj = 0; bj < 2; ++bj) g[ai][m][bj] = *(const u32x2*)(GB + off0 + (size_t)(ai * HALF + m * 16) * D + bj * HALF);
#pragma unroll
            for (int ai = 0; ai < 2; ++ai)
#pragma unroll
                for (int m = 0; m < 4; ++m)
#pragma unroll
                    for (int bj = 0; bj < 2; ++bj) { f32x4 v0 = acc[ai][bj][m][0], v1 = acc[ai][bj][m][1]; gate8c(v0, v1, g[ai][m][bj]);
                        u32x2 w8; w8.x = pk4_fp8(v0.x, v0.y, v0.z, v0.w); w8.y = pk4_fp8(v1.x, v1.y, v1.z, v1.w);
                        *(u32x2*)(MRG8 + off0 + (size_t)(ai * HALF + m * 16) * D + bj * HALF) = w8; }
        }
    }
};
struct EpiOut {
    static constexpr bool PERM = true; static constexpr bool KEEP = false;
    const float* x; bf16_t* X1; const float* mod; float* ssq;
    __device__ __forceinline__ void operator()(const Acc& acc, const Unit& u, int wr, int wc, int fr, int fq, LAS unsigned char*) const {
        const int row0 = u.pm * BM + wr * 64 + fr, col0 = u.pn * BM + wc * 32 + 8 * fq, b = (u.pm * BM) >> 11;
        const float* gt = mod + (size_t)b * 6 * D + 2 * D + col0;
        f32x4 gv[2][2];
#pragma unroll
        for (int bj = 0; bj < 2; ++bj)
#pragma unroll
            for (int n = 0; n < 2; ++n) gv[bj][n] = *(const f32x4*)(gt + bj * HALF + n * 4);
#pragma unroll
        for (int ai = 0; ai < 2; ++ai) {
            f32x4 xv[4][2][2];
#pragma unroll
            for (int m = 0; m < 4; ++m)
#pragma unroll
                for (int bj = 0; bj < 2; ++bj)
#pragma unroll
                    for (int n = 0; n < 2; ++n) xv[m][bj][n] = *(const f32x4*)(x + (size_t)(row0 + ai * HALF + m * 16) * D + col0 + bj * HALF + n * 4);
#pragma unroll
            for (int m = 0; m < 4; ++m) { const int row = row0 + ai * HALF + m * 16; const size_t off = (size_t)row * D + col0; float s = 0.f;
#pragma unroll
                for (int bj = 0; bj < 2; ++bj) { const f32x4 v0 = xv[m][bj][0] + gv[bj][0] * acc[ai][bj][m][0], v1 = xv[m][bj][1] + gv[bj][1] * acc[ai][bj][m][1];
                    s += dot8(v0, v1); ST16(X1 + off + bj * HALF, pack8(v0, v1)); }
                s += __shfl_xor(s, 16); s += __shfl_xor(s, 32);
                if (fq == 0) ssq[(size_t)row * 32 + u.pn * 4 + wc] = s; }
        }
    }
};
struct EpiGu {
    static constexpr bool PERM = true; static constexpr bool KEEP = false;
    bf16_t* ACT;
    __device__ __forceinline__ void operator()(const Acc& acc, const Unit& u, int wr, int wc, int fr, int fq, LAS unsigned char*) const {
        const int rl0 = wr * 64 + fr, cw = wc * 32 + 8 * fq;
#pragma unroll
        for (int ai = 0; ai < 2; ++ai)
#pragma unroll
            for (int m = 0; m < 4; ++m) { const int rl = rl0 + ai * HALF + m * 16;
                f32x4 r[2];
#pragma unroll
                for (int n = 0; n < 2; ++n) {
                    const f32x4 g = acc[ai][0][m][n], up = acc[ai][1][m][n];
                    r[n].x = g.x * sigmoidf_fast(g.x) * up.x; r[n].y = g.y * sigmoidf_fast(g.y) * up.y; r[n].z = g.z * sigmoidf_fast(g.z) * up.z; r[n].w = g.w * sigmoidf_fast(g.w) * up.w; }
                u32x2 w8; w8.x = pk4_fp8(r[0].x, r[0].y, r[0].z, r[0].w); w8.y = pk4_fp8(r[1].x, r[1].y, r[1].z, r[1].w);
                *(u32x2*)((unsigned char*)ACT + ((size_t)u.aux * CAP + rl) * FF + u.pn * HALF + cw) = w8; }
    }
};
struct EpiDn {
    static constexpr bool PERM = true; static constexpr bool KEEP = false;
    unsigned char* Y; const float* val;
    __device__ __forceinline__ void operator()(const Acc& acc, const Unit& u, int wr, int wc, int fr, int fq, LAS unsigned char*) const {
        const int rl0 = wr * 64 + fr, cw = wc * 32 + 8 * fq;
        float vv[2][4];
#pragma unroll
        for (int ai = 0; ai < 2; ++ai)
#pragma unroll
            for (int m = 0; m < 4; ++m) vv[ai][m] = val[u.aux * CAP + rl0 + ai * HALF + m * 16] * Y_SCALE;
#pragma unroll
        for (int ai = 0; ai < 2; ++ai)
#pragma unroll
            for (int m = 0; m < 4; ++m) { const int rl = rl0 + ai * HALF + m * 16; const float v = vv[ai][m];
#pragma unroll
                for (int bj = 0; bj < 2; ++bj) { const f32x4 v0 = acc[ai][bj][m][0] * v, v1 = acc[ai][bj][m][1] * v;
                    u32x2 w8; w8.x = pk4_fp8(v0.x, v0.y, v0.z, v0.w); w8.y = pk4_fp8(v1.x, v1.y, v1.z, v1.w);
                    *(u32x2*)(Y + ((size_t)u.aux * CAP + rl) * D + u.pn * BM + bj * HALF + cw) = w8; } }
    }
};
}

namespace at {
constexpr int NW = 8, QBLK = 32, KVBLK = 64, DV = 128;
constexpr float THR2 = 8.f;
#define SBAR() __builtin_amdgcn_sched_barrier(0)
__device__ __forceinline__ int crow(int r, int hi) { return (r & 3) + 8 * (r >> 2) + 4 * hi; }
__device__ __forceinline__ void partialSM(f32x16& p0, f32x16& p1, float& m_reg, float& alpha, f32x16& negm, const bool first) {
    float pmax = p0[0];
#pragma unroll
    for (int r = 1; r < 16; ++r) pmax = fmaxf(pmax, p0[r]);
#pragma unroll
    for (int r = 0; r < 16; ++r) pmax = fmaxf(pmax, p1[r]);
    { auto rr = __builtin_amdgcn_permlane32_swap(__float_as_uint(pmax), __float_as_uint(pmax), false, false);
      pmax = fmaxf(__uint_as_float(rr[0]), __uint_as_float(rr[1])); }
    if (__builtin_expect(!first && __all(pmax <= THR2), 1)) { alpha = 1.f; }
    else { const float d = first ? pmax : fmaxf(pmax, 0.f); alpha = first ? 1.f : __builtin_amdgcn_exp2f(-d); m_reg += d;
           { const float nd = -d; p0 = p0 + nd; p1 = p1 + nd; }
           const float nm = -m_reg;
#pragma unroll
           for (int r = 0; r < 16; ++r) negm[r] = nm; }
#pragma unroll
    for (int r = 0; r < 16; ++r) p0[r] = __builtin_amdgcn_exp2f(p0[r]);
}
typedef int v8i __attribute__((ext_vector_type(8)));
__device__ __forceinline__ void finishSM(f32x16& p0, f32x16& p1, float alpha, float& l_reg, v8i& pa) {
#pragma unroll
    for (int r = 0; r < 16; ++r) p1[r] = __builtin_amdgcn_exp2f(p1[r]);
    float ps;
    { typedef float f32x8v __attribute__((ext_vector_type(8))); typedef float f32x2v __attribute__((ext_vector_type(2)));
      const f32x16 t16 = p0 + p1; const f32x8v t8 = t16.lo + t16.hi; const f32x4 t4 = t8.lo + t8.hi; const f32x2v t2 = t4.lo + t4.hi; ps = t2.x + t2.y; }
    { auto rr = __builtin_amdgcn_permlane32_swap(__float_as_uint(ps), __float_as_uint(ps), false, false);
      ps = __uint_as_float(rr[0]) + __uint_as_float(rr[1]); }
    l_reg = l_reg * alpha + ps;
#pragma unroll
    for (int w = 0; w < 4; ++w) { pa[w] = (int)pk4_fp8(p0[4 * w], p0[4 * w + 1], p0[4 * w + 2], p0[4 * w + 3]); pa[4 + w] = (int)pk4_fp8(p1[4 * w], p1[4 * w + 1], p1[4 * w + 2], p1[4 * w + 3]); }
}
constexpr int VROW = 80;
__device__ __forceinline__ v8i vfrag(int vb, int d) { const pg::v4i lo = *(const LAS pg::v4i*)(size_t)(vb + d * 32 * VROW), hi4 = *(const LAS pg::v4i*)(size_t)(vb + d * 32 * VROW + 16); return __builtin_shufflevector(lo, hi4, 0, 1, 2, 3, 4, 5, 6, 7); }
__device__ __forceinline__ void pv_d0(f32x16* o, int vb, const v8i pa) {
    const int one = 0x7F7F7F7F;
    v8i vf[2]; vf[0] = vfrag(vb, 0);
    asm volatile("s_nop 4" ::: "memory");
#pragma unroll
    for (int d = 0; d < 4; ++d) {
        if (d + 1 < 4) vf[(d + 1) & 1] = vfrag(vb, d + 1);
        asm volatile("v_mfma_scale_f32_32x32x64_f8f6f4 %0, %1, %2, %0, %3, %4 op_sel_hi:[0,0,0]" : "+v"(o[d]) : "v"(pa), "v"(vf[d & 1]), "v"(one), "v"(one)); }
}
template <int DQK, int LDQ, int LDK1, int SDEPTH>
__device__ __forceinline__ void attn_unit(const unsigned char* __restrict__ Qb, const unsigned char* __restrict__ K1h, const unsigned char* __restrict__ K2, const unsigned char* __restrict__ Vimg  ,
                                          unsigned char* __restrict__ Ob, LAS unsigned char* lds) {
    constexpr int KROW = DQK + 16  , SHM_V = DV * VROW  , SHM_K = KVBLK * KROW, NKS = DQK / 64  ;
    constexpr bool HAS2 = (DQK == 192);
    const int wid = __builtin_amdgcn_readfirstlane(threadIdx.x >> 6);
    int lane = threadIdx.x & 63; asm volatile("" : "+v"(lane));
    const int tid = wid * 64 + lane, r32 = lane & 31, hi = lane >> 5;
    LAS unsigned char* V_lds = lds; LAS unsigned char* K_lds = lds + 3 * SHM_V;
    LAS float* wsf = (LAS float*)(lds + 3 * SHM_V + 3 * SHM_K) + wid * 64; LAS float* li_l = wsf; LAS float* al_l = wsf + 32;
    static_assert(3 * SHM_V + 3 * SHM_K + 2048 <= MISC_OFF && NW * 4096 <= MISC_OFF, "attention LDS image fits below the barrier words");
    float m_reg = 0.f, l_reg = 0; f32x16 o[4] = {}; f32x16 negm = {};
    v8i qf[NKS];
    { const unsigned char* Qw = Qb + (size_t)(wid * QBLK + r32) * LDQ + hi * 32;
#pragma unroll
      for (int ks = 0; ks < NKS; ++ks) { const pg::v4i lo = *(const pg::v4i*)(Qw + ks * 64), h4 = *(const pg::v4i*)(Qw + ks * 64 + 16); qf[ks] = __builtin_shufflevector(lo, h4, 0, 1, 2, 3, 4, 5, 6, 7); } }
    const int kr1 = tid >> 3, kc1 = (tid & 7) * 16;
    const int kr2 = (tid & 255) >> 2, kc2 = (tid & 3) * 16;
    const int vb0 = (int)(size_t)V_lds + r32 * VROW + hi * 32;
    const int kb0 = (int)(size_t)K_lds + r32 * KROW + hi * 32;
    constexpr int SE = 0;
    bf16x8 sV0[SDEPTH], sK0[SDEPTH], sK2[SDEPTH];
    const __amdgpu_buffer_rsrc_t rV = __builtin_amdgcn_make_buffer_rsrc((void*)Vimg, 0, 0x7fffffff, 0x00020000), rK1 = __builtin_amdgcn_make_buffer_rsrc((void*)K1h, 0, 0x7fffffff, 0x00020000);
    const __amdgpu_buffer_rsrc_t rK2 = __builtin_amdgcn_make_buffer_rsrc((void*)(HAS2 ? K2 : K1h), 0, 0x7fffffff, 0x00020000);
    const int voV = tid * 16, vwV = (tid >> 2) * VROW + (tid & 3) * 16, voK = kr1 * LDK1 + kc1, voK2 = kr2 * 64 + kc2;
#define BLD(r, vo, so) __builtin_bit_cast(bf16x8, __builtin_amdgcn_raw_buffer_load_b128(r, vo, so, 0))
#define SLOAD(i, k0) do { sV0[i] = BLD(rV, voV, (k0) * DV); sK0[i] = BLD(rK1, voK, (k0) * LDK1); \
    if constexpr (HAS2) sK2[i] = BLD(rK2, voK2, (k0) * 64); } while (0)
#define SWRITE(b, i) do { *(LAS bf16x8*)(V_lds + (b) * SHM_V + vwV) = sV0[i]; *(LAS bf16x8*)(K_lds + (b) * SHM_K + kr1 * KROW + kc1) = sK0[i]; \
    if constexpr (HAS2) { if (wid < 4) *(LAS bf16x8*)(K_lds + (b) * SHM_K + kr2 * KROW + 128 + kc2) = sK2[i]; } } while (0)
#define SWAIT() do { if constexpr (HAS2) asm volatile("s_waitcnt vmcnt(3)" ::: "memory"); else asm volatile("s_waitcnt vmcnt(2)" ::: "memory"); } while (0)
#define RESC(a) do { if (__any((a) < 1.f)) { if (hi == 0) al_l[r32] = (a); asm volatile("s_waitcnt lgkmcnt(0)" ::: "memory"); \
    _Pragma("unroll") for (int d = 0; d < 4; ++d) _Pragma("unroll") for (int r = 0; r < 16; ++r) o[d][r] *= al_l[crow(r, hi)]; } } while (0)
#define KFRAG(dst, blk, ks, KBOFF) do { const pg::v4i lo_ = *(const LAS pg::v4i*)(size_t)(kb0 + (KBOFF) + (blk) * 32 * KROW + (ks) * 64), h4_ = *(const LAS pg::v4i*)(size_t)(kb0 + (KBOFF) + (blk) * 32 * KROW + (ks) * 64 + 16); \
        dst = __builtin_shufflevector(lo_, h4_, 0, 1, 2, 3, 4, 5, 6, 7); } while (0)
#define QKT(P0, P1, KBOFF) do { const int one_ = 0x7F7F7F7F, qsc_ = 0x7B7B7B7B; v8i ka_[2][2];     \
    KFRAG(ka_[0][0], 0, 0, KBOFF); KFRAG(ka_[0][1], 1, 0, KBOFF); \
    _Pragma("unroll") for (int ks = 0; ks < NKS; ++ks) { \
        if (ks + 1 < NKS) { KFRAG(ka_[(ks + 1) & 1][0], 0, ks + 1, KBOFF); KFRAG(ka_[(ks + 1) & 1][1], 1, ks + 1, KBOFF); } \
        if (ks == 0) { \
            asm volatile("v_mfma_scale_f32_32x32x64_f8f6f4 %0, %1, %2, %3, %4, %5 op_sel_hi:[0,0,0]" : "=&v"(P0) : "v"(ka_[0][0]), "v"(qf[0]), "v"(negm), "v"(one_), "v"(qsc_)); \
            asm volatile("v_mfma_scale_f32_32x32x64_f8f6f4 %0, %1, %2, %3, %4, %5 op_sel_hi:[0,0,0]" : "=&v"(P1) : "v"(ka_[0][1]), "v"(qf[0]), "v"(negm), "v"(one_), "v"(qsc_)); \
        } else { \
            asm volatile("v_mfma_scale_f32_32x32x64_f8f6f4 %0, %1, %2, %0, %3, %4 op_sel_hi:[0,0,0]" : "+v"(P0) : "v"(ka_[ks & 1][0]), "v"(qf[ks]), "v"(one_), "v"(qsc_)); \
            asm volatile("v_mfma_scale_f32_32x32x64_f8f6f4 %0, %1, %2, %0, %3, %4 op_sel_hi:[0,0,0]" : "+v"(P1) : "v"(ka_[ks & 1][1]), "v"(qf[ks]), "v"(one_), "v"(qsc_)); } } \
    asm volatile("s_nop 15\n\ts_nop 7" ::: "memory"); } while (0)
    f32x16 pA0, pA1, pB0, pB1; float alA, alB; v8i pa; constexpr int NT = S / KVBLK;
    static_assert(SDEPTH == 2, "three LDS buffers fed through two register sets");
    int bc = 0, bn = 1, bw = 2;
#define STEP(t, SET, C0, C1, ALC, N0, N1, ALN) do { \
        SBAR(); QKT(N0, N1, bn * SHM_K); \
        finishSM(C0, C1, ALC, l_reg, pa); SBAR(); \
        SLOAD(1 - (SET), (((t) + 3 < NT) ? (t) + 3 : NT - 1) * KVBLK); SBAR();     \
        pv_d0(o, vb0 + bc * SHM_V, pa); partialSM(N0, N1, m_reg, ALN, negm, false);              \
        SWAIT(); if ((t) + 2 < NT) SWRITE(bw, SET); \
        RESC(ALN); __syncthreads(); \
        { const int tb = bc; bc = bn; bn = bw; bw = tb; } } while (0)
    SLOAD(0, 0); SLOAD(1, KVBLK); asm volatile("s_waitcnt vmcnt(0)" ::: "memory"); SWRITE(0, 0); SWRITE(1, 1); SLOAD(0, 2 * KVBLK); __syncthreads();
    QKT(pA0, pA1, 0); partialSM(pA0, pA1, m_reg, alA, negm, true);
    for (int t = 0; t + 2 < NT; t += 2) { STEP(t, 0, pA0, pA1, alA, pB0, pB1, alB); STEP(t + 1, 1, pB0, pB1, alB, pA0, pA1, alA); }
    STEP(NT - 2, 0, pA0, pA1, alA, pB0, pB1, alB);
    finishSM(pB0, pB1, alB, l_reg, pa); SBAR();
    pv_d0(o, vb0 + bc * SHM_V, pa);
    asm volatile("s_nop 15\n\ts_nop 15" ::: "memory");
#undef STEP
    __builtin_amdgcn_s_setprio(0);
    if (hi == 0) li_l[r32] = l_reg;
    asm volatile("s_waitcnt lgkmcnt(0)" ::: "memory");
    __syncthreads();
    float rli[16];
#pragma unroll
    for (int r = 0; r < 16; ++r) rli[r] = __builtin_amdgcn_rcpf(li_l[crow(r, hi)]);
    LAS unsigned char* stg = lds + wid * 4096;
#pragma unroll
    for (int r = 0; r < 16; ++r) { const int orow = crow(r, hi);
#pragma unroll
        for (int d0 = 0; d0 < 4; ++d0) { const float v = o[d0][r] * rli[r]; stg[orow * 128 + d0 * 32 + r32] = (unsigned char)(__builtin_amdgcn_cvt_pk_fp8_f32(v, v, 0, false) & 0xffu); } }
    asm volatile("s_waitcnt lgkmcnt(0)" ::: "memory");
    unsigned char* Ow = Ob + (size_t)(wid * QBLK) * 1024;
#pragma unroll
    for (int i = 0; i < 8; ++i) { const int row = i * 4 + (lane >> 4), ch = lane & 15; const u32x2 v = *(const LAS u32x2*)(stg + row * 128 + ch * 8); *(u32x2*)(Ow + (size_t)row * 1024 + ch * 8) = v; }
    asm volatile("s_waitcnt lgkmcnt(0)" ::: "memory");
    __syncthreads();
#undef SLOAD
#undef BLD
#undef SWRITE
#undef SWAIT
#undef RESC
#undef QKT
#undef KFRAG
}
#undef SBAR
}

struct MArgs { const float* in[21]; float* out; unsigned char* ws; int ph_lo, ph_hi, li, pad; };

template <bool OUT8 = false, class RowMap>
__device__ __forceinline__ void conv_item(const float* __restrict__ W, int ldw, int K, int k0, int n0, bf16_t* __restrict__ WT, const float* __restrict__ kscale, LAS float* scr, int lane, const RowMap& rowmap) {
#pragma unroll 8
    for (int i = 0; i < 32; ++i) { const int kk = 2 * i + (lane >> 5); float v = W[(size_t)(k0 + kk) * ldw + n0 + (lane & 31)]; if (kscale) v *= kscale[k0 + kk]; scr[kk * 33 + (lane & 31)] = v; }
    asm volatile("s_waitcnt lgkmcnt(0)" ::: "memory");
    const int c = lane & 7;
#pragma unroll
    for (int j = 0; j < 4; ++j) { const int n = (lane >> 3) + 8 * j; const LAS float* s = scr + (8 * c) * 33 + n;
        if constexpr (OUT8) { u32x2 o; o.x = pk4_fp8(s[0 * 33] * W8_SCALE, s[1 * 33] * W8_SCALE, s[2 * 33] * W8_SCALE, s[3 * 33] * W8_SCALE); o.y = pk4_fp8(s[4 * 33] * W8_SCALE, s[5 * 33] * W8_SCALE, s[6 * 33] * W8_SCALE, s[7 * 33] * W8_SCALE);
            *(u32x2*)((unsigned char*)WT + (size_t)rowmap(n0 + n) * K + k0 + 8 * c) = o; }
        else { u32x4 o; o.x = pk2(s[0 * 33], s[1 * 33]); o.y = pk2(s[2 * 33], s[3 * 33]); o.z = pk2(s[4 * 33], s[5 * 33]); o.w = pk2(s[6 * 33], s[7 * 33]);
            *(u32x4*)(WT + (size_t)rowmap(n0 + n) * K + k0 + 8 * c) = o; } }
    asm volatile("s_waitcnt lgkmcnt(0)" ::: "memory");
}
__device__ __forceinline__ int il64(int j) { return (j < 32) ? 2 * j : 2 * (j - 32) + 1; }
__device__ __forceinline__ int il128(int d) { return (d & 64) + il64(d & 63); }
struct MapIn { __device__ __forceinline__ int operator()(int n) const {
    if (n < C_KR) return n; if (n < C_QG) return 768 + il64(n - C_KR);
    if (n < C_KG) { const int m = n - C_QG; return 1024 + (m & ~127) + il128(m & 127); }
    if (n < C_VG) { const int m = n - C_KG; return 2048 + (m & ~127) + il128(m & 127); }
    if (n < C_GA) return 2304 + (n - C_VG); if (n < C_GB) return 2560 + (n - C_GA); return 4608 + (n - C_GB); } };
struct MapUq { __device__ __forceinline__ int operator()(int n) const { const int h = n / 192, j = n - h * 192; return j < 128 ? n : h * 192 + 128 + il64(j - 128); } };
struct MapId { int off; __device__ __forceinline__ int operator()(int n) const { return off + n; } };
struct MapGu { int base; __device__ __forceinline__ int operator()(int f) const { return base + (f >> 7) * 256 + (f & 127); } };

__device__ __forceinline__ void phase_modp(const MArgs& a, LAS unsigned char* lds, int vcu, int G, int tid, int lane, int wave) {
    unsigned char* ws = a.ws;
    { const int gt = vcu * NTHR + tid, nitem = MOD_SPLIT * (6 * D / 4);
      const float* c = a.in[1]; const float* w_ada = a.in[2]; float* modp = (float*)(ws + WS_MODP);
      for (int it = gt; it < nitem; it += G * NTHR) {
          const int sp = it / (6 * D / 4), cg = it - sp * (6 * D / 4), k0 = sp * (D / MOD_SPLIT);
          f32x4 acc[NB];
#pragma unroll
          for (int b = 0; b < NB; ++b) acc[b] = (f32x4){0.f, 0.f, 0.f, 0.f};
#pragma unroll 4
          for (int k = 0; k < D / MOD_SPLIT; ++k) {
              const f32x4 w = *(const f32x4*)(w_ada + (size_t)(k0 + k) * (6 * D) + 4 * cg);
#pragma unroll
              for (int b = 0; b < NB; ++b) { const float cv = c[b * D + k0 + k]; const float sv = cv * sigmoidf_fast(cv); acc[b] += w * sv; }
          }
#pragma unroll
          for (int b = 0; b < NB; ++b) *(f32x4*)(modp + ((size_t)sp * NB + b) * (6 * D) + 4 * cg) = acc[b];
      } }
    { float* tab = (float*)(ws + WS_TAB); float* gp = (float*)(ws + WS_GP);
      for (int t = vcu * NTHR + tid; t < 2048 * 32; t += G * NTHR) {
          const int pos = t >> 5, i = t & 31;
          double f = 1.0; for (int j = 0; j < i; ++j) f *= 0.74989420933245582730;
          const float ff = (float)f; const float ang = (float)pos * ff;
          double s, c; sincos_d((double)ang, s, c);
          tab[2 * t] = (float)c; tab[2 * t + 1] = (float)s;
      }
      if (vcu == 0 && tid < 128) { gp[tid] = a.in[10][perm_old_dim(tid)]; gp[128 + tid] = a.in[11][perm_old_dim(tid)]; } }
    { LAS float* scr = (LAS float*)(lds + wave * 8448);
      const int gw = vcu * NWAVES + wave, NGW = G * NWAVES;
      constexpr int I_IN = (D / 64) * (IN_COLS / 32), I_UQ = (512 / 64) * (1536 / 32), I_UKV = (256 / 64) * (2048 / 32), I_BR = (1024 / 64) * (2048 / 32), I_OUT = (2048 / 64) * (2048 / 32);
      constexpr int NITEMS = I_IN + I_UQ + I_UKV + 2 * I_BR + I_OUT;
      for (int it = gw; it < NITEMS; it += NGW) {
          int r = it;
          if (r < I_IN) { const int nb = IN_COLS / 32; conv_item<true>(a.in[5], IN_COLS, D, 64 * (r / nb), 32 * (r % nb), (bf16_t*)(ws + WS_WIN), nullptr, scr, lane, MapIn{}); continue; } r -= I_IN;
          if (r < I_UQ) { const int nb = 1536 / 32; conv_item<true>(a.in[8], 1536, 512, 64 * (r / nb), 32 * (r % nb), (bf16_t*)(ws + WS_WUQ), a.in[6], scr, lane, MapUq{}); continue; } r -= I_UQ;
          if (r < I_UKV) { const int nb = 2048 / 32; conv_item<true>(a.in[9], 2048, 256, 64 * (r / nb), 32 * (r % nb), (bf16_t*)(ws + WS_WUKV), a.in[7], scr, lane, MapId{0}); continue; } r -= I_UKV;
          if (r < I_BR) { const int nb = 2048 / 32; conv_item<true>(a.in[12], 2048, 1024, 64 * (r / nb), 32 * (r % nb), (bf16_t*)(ws + WS_WBRA), nullptr, scr, lane, MapId{0}); continue; } r -= I_BR;
          if (r < I_BR) { const int nb = 2048 / 32; conv_item<true>(a.in[13], 2048, 1024, 64 * (r / nb), 32 * (r % nb), (bf16_t*)(ws + WS_WBRB), nullptr, scr, lane, MapId{0}); continue; } r -= I_BR;
          { const int nb = 2048 / 32; conv_item<true>(a.in[14], 2048, 2048, 64 * (r / nb), 32 * (r % nb), (bf16_t*)(ws + WS_WOUT), nullptr, scr, lane, MapId{0}); }
      }
      u32x4* z = (u32x4*)(ws + WS_WIN + (size_t)832 * D);
      for (int t = vcu * NTHR + tid; t < 192 * D / 16; t += G * NTHR) z[t] = (u32x4){0u, 0u, 0u, 0u};
    }
}
struct ConvIt { const float* W; int k0, n0, rowbase; };
template <int NB_, bool GU>
__device__ __forceinline__ void conv_items(const ConvIt (&it)[NB_], int ldw, int K, unsigned char* __restrict__ WT, LAS float* scr, int lane) {
    const int kr = lane >> 3, nq = lane & 7, c = lane & 7;
    f32x4 v[NB_][8];
#pragma unroll
    for (int b = 0; b < NB_; ++b)
#pragma unroll
        for (int i = 0; i < 8; ++i) v[b][i] = *(const f32x4*)(it[b].W + (size_t)(it[b].k0 + 8 * i + kr) * ldw + it[b].n0 + 4 * nq);
#pragma unroll
    for (int b = 0; b < NB_; ++b) {
#pragma unroll
        for (int i = 0; i < 8; ++i) *(LAS f32x4*)(scr + (8 * i + kr) * 32 + 4 * (nq ^ i)) = v[b][i];
        asm volatile("s_waitcnt lgkmcnt(0)" ::: "memory");
        { const int q4 = lane >> 3; f32x4 r[8];
#pragma unroll
          for (int i = 0; i < 8; ++i) r[i] = *(const LAS f32x4*)(scr + (8 * c + i) * 32 + 4 * (q4 ^ c)) * W8_SCALE;
#pragma unroll
          for (int e = 0; e < 4; ++e) { const int nn = it[b].n0 + 4 * q4 + e;
            const int drow = GU ? it[b].rowbase + (nn >> 7) * 256 + (nn & 127) : it[b].rowbase + nn;
            u32x2 o; o.x = pk4_fp8(r[0][e], r[1][e], r[2][e], r[3][e]); o.y = pk4_fp8(r[4][e], r[5][e], r[6][e], r[7][e]);
            *(u32x2*)(WT + (size_t)drow * K + it[b].k0 + 8 * c) = o; } }
        asm volatile("s_waitcnt lgkmcnt(0)" ::: "memory");
    }
}
__device__ __forceinline__ void phase_expert_conv(const MArgs& a, LAS unsigned char* lds, int gw, int NGW, int lane, int wave, int slot, int nslots) {
    unsigned char* ws = a.ws; LAS float* scr = (LAS float*)(lds + wave * 8448);
    constexpr int I_G1 = (D / 64) * (FF / 32), I_GU = NE * I_G1, I_D1 = (FF / 64) * (D / 32), I_DN = NE * I_D1, NBAT = 2;
    const int step = nslots * NGW;
    for (int fam = 0; fam < 3; ++fam) {
        const int NI = fam < 2 ? I_GU : I_DN;
        for (int it0 = gw + slot * NGW; it0 < NI; it0 += NBAT * step) {
            ConvIt ci[NBAT];
#pragma unroll
            for (int b = 0; b < NBAT; ++b) { const int it = (it0 + b * step < NI) ? it0 + b * step : it0;
                if (fam < 2) { const int e = it / I_G1, q = it % I_G1, nb = FF / 32; ci[b] = ConvIt{a.in[17 + fam] + (size_t)e * D * FF, 64 * (q / nb), 32 * (q % nb), e * 2048 + fam * 128}; }
                else { const int e = it / I_D1, q = it % I_D1, nb = D / 32; ci[b] = ConvIt{a.in[19] + (size_t)e * FF * D, 64 * (q / nb), 32 * (q % nb), e * 2048}; } }
            if (fam < 2) conv_items<NBAT, true>(ci, FF, D, ws + WS_WGU, scr, lane);
            else conv_items<NBAT, false>(ci, D, FF, ws + WS_WDN, scr, lane);
        }
    }
    __syncthreads();
}
__device__ __forceinline__ void modr_all(const MArgs& a, int vcu, int G, int tid) {
    const float* modp = (const float*)(a.ws + WS_MODP); float* mod = (float*)(a.ws + WS_MOD); const float* b_ada = a.in[3];
    constexpr int N = NB * 6 * D / 4; const int per = (N + G - 1) / G;
    for (int i = tid; i < per; i += NTHR) {
        const int t = vcu * per + i; if (t >= N) break;
        const int b = t / (6 * D / 4), cg = t - b * (6 * D / 4);
        f32x4 s = *(const f32x4*)(b_ada + 4 * cg);
        for (int sp = 0; sp < MOD_SPLIT; ++sp) s += *(const f32x4*)(modp + ((size_t)sp * NB + b) * (6 * D) + 4 * cg);
        *(f32x4*)(mod + (size_t)b * 6 * D + 4 * cg) = s;
    }
}
__device__ __forceinline__ void phase_xn(const MArgs& a, LAS unsigned char* lds, int vcu, int G, int tid, int lane, int wave) {
    const float* x = a.in[0]; const float* g = a.in[4]; const float* modp = (const float*)(a.ws + WS_MODP); const float* b_ada = a.in[3]; unsigned char* xn = a.ws + WS_XN;
    LAS f32x4* GM = (LAS f32x4*)lds; LAS f32x4* SH = GM + D / 4;
    for (int blk = vcu; blk < M / 64; blk += G) {
        const int b = blk >> 5;
        for (int i = tid; i < D / 2; i += NTHR) {
            f32x4 s = *(const f32x4*)(b_ada + 4 * i);
            for (int sp = 0; sp < MOD_SPLIT; ++sp) s += *(const f32x4*)(modp + ((size_t)sp * NB + b) * (6 * D) + 4 * i);
            if (i < D / 4) SH[i] = s; else GM[i - D / 4] = ((const f32x4*)g)[i - D / 4] * (1.f + s);
        }
        __syncthreads();
        for (int r = wave; r < 64; r += NWAVES) {
            const int row = blk * 64 + r;
            const f32x4* xr = (const f32x4*)(x + (size_t)row * D) + lane;
            f32x4 v[8]; float s = 0.f;
#pragma unroll
            for (int j = 0; j < 8; ++j) { v[j] = xr[64 * j]; s += v[j].x * v[j].x + v[j].y * v[j].y + v[j].z * v[j].z + v[j].w * v[j].w; }
            const float rstd = rsqrtf(wave_sum(s) * (1.f / D) + EPS);
            unsigned* o = (unsigned*)(xn + (size_t)row * D) + lane;
#pragma unroll
            for (int j = 0; j < 8; ++j) { const f32x4 y = v[j] * rstd * GM[64 * j + lane] + SH[64 * j + lane]; o[64 * j] = pk4_fp8(y.x, y.y, y.z, y.w); }
        }
        __syncthreads();
    }
    modr_all(a, vcu, G, tid);
}
__device__ __forceinline__ void split8(const f32x4 y0, const f32x4 y1, bf16x8& hi, bf16x8& lo) {
    const u32x4 h = pack8(y0, y1);
    const f32x4 r0 = y0 - (f32x4){bflo(h.x), bfhi(h.x), bflo(h.y), bfhi(h.y)}, r1 = y1 - (f32x4){bflo(h.z), bfhi(h.z), bflo(h.w), bfhi(h.w)};
    hi = __builtin_bit_cast(bf16x8, h); lo = __builtin_bit_cast(bf16x8, pack8(r0, r1)); }
__device__ __forceinline__ void phase_router(const MArgs& a, LAS unsigned char* lds, int vcu, int G, int lane, int tid, int wave) {
    const bf16_t* x1 = (const bf16_t*)(a.ws + WS_X1); const float* ssq = (const float*)(a.ws + WS_SSQX1); const float* g = a.in[15]; const float* mod = (const float*)(a.ws + WS_MOD); const float* wr = a.in[16];
    unsigned char* h2 = a.ws + WS_H2; float* aff = (float*)(a.ws + WS_AFF); int* rank = (int*)(a.ws + WS_RANK);
    LAS float* GM = (LAS float*)lds; LAS float* SH = GM + D;
    LAS f32x4* PART = (LAS f32x4*)(lds + 2 * D * 4);
    const int fr = lane & 15, fq = lane >> 4, k0 = wave * 256 + 8 * fq;
    bf16x8 whi[8], wlo[8];
#pragma unroll
    for (int s = 0; s < 8; ++s) { f32x4 w0, w1;
#pragma unroll
        for (int i = 0; i < 4; ++i) { w0[i] = wr[(size_t)(k0 + 32 * s + i) * NE + fr]; w1[i] = wr[(size_t)(k0 + 32 * s + 4 + i) * NE + fr]; }
        split8(w0, w1, whi[s], wlo[s]); }
    for (int blk = vcu; blk < M / 64; blk += G) {
        const int b = blk >> 5;
        const float* sh = mod + (size_t)b * 6 * D + 3 * D; const float* sc = sh + D;
        for (int i = tid; i < D / 4; i += NTHR) { const f32x4 gg = ((const f32x4*)g)[i], cc = ((const f32x4*)sc)[i]; ((LAS f32x4*)GM)[i] = gg * (1.f + cc); ((LAS f32x4*)SH)[i] = ((const f32x4*)sh)[i]; }
        __syncthreads();
#pragma unroll 1
        for (int tp = 0; tp < 4; tp += 2) {
            int rowt[2]; f32x4 q0[2], q1[2]; u32x4 xw[2][8];
#pragma unroll
            for (int u = 0; u < 2; ++u) { rowt[u] = blk * 64 + 16 * (tp + u) + fr;
                q0[u] = *(const f32x4*)(ssq + (size_t)rowt[u] * 32 + 8 * fq); q1[u] = *(const f32x4*)(ssq + (size_t)rowt[u] * 32 + 8 * fq + 4);
#pragma unroll
                for (int s = 0; s < 8; ++s) xw[u][s] = *(const u32x4*)(x1 + (size_t)rowt[u] * D + k0 + 32 * s); }
#pragma unroll
            for (int u = 0; u < 2; ++u) {
                asm volatile("" ::: "memory");
                const int row = rowt[u];
                float sq = ((q0[u].x + q0[u].y) + (q0[u].z + q0[u].w)) + ((q1[u].x + q1[u].y) + (q1[u].z + q1[u].w));
                sq += __shfl_xor(sq, 16); sq += __shfl_xor(sq, 32);
                const float rstd = rsqrtf(sq * (1.f / D) + EPS);
                f32x4 acc = (f32x4){0.f, 0.f, 0.f, 0.f};
#pragma unroll
                for (int s = 0; s < 8; ++s) {
                    const int k = k0 + 32 * s;
                    const f32x4 g0 = *(const LAS f32x4*)(GM + k), g1 = *(const LAS f32x4*)(GM + k + 4), s0 = *(const LAS f32x4*)(SH + k), s1 = *(const LAS f32x4*)(SH + k + 4);
                    const f32x4 y0 = (f32x4){bflo(xw[u][s].x), bfhi(xw[u][s].x), bflo(xw[u][s].y), bfhi(xw[u][s].y)} * rstd * g0 + s0;
                    const f32x4 y1 = (f32x4){bflo(xw[u][s].z), bfhi(xw[u][s].z), bflo(xw[u][s].w), bfhi(xw[u][s].w)} * rstd * g1 + s1;
                    u32x2 w8; w8.x = pk4_fp8(y0.x, y0.y, y0.z, y0.w); w8.y = pk4_fp8(y1.x, y1.y, y1.z, y1.w);
                    *(u32x2*)(h2 + (size_t)row * D + k) = w8;
                    bf16x8 hi, lo; split8(y0, y1, hi, lo);
                    acc = __builtin_amdgcn_mfma_f32_16x16x32_bf16(whi[s], hi, acc, 0, 0, 0);
                    acc = __builtin_amdgcn_mfma_f32_16x16x32_bf16(wlo[s], hi, acc, 0, 0, 0);
                    acc = __builtin_amdgcn_mfma_f32_16x16x32_bf16(whi[s], lo, acc, 0, 0, 0);
                }
                PART[((tp + u) * 8 + wave) * 64 + lane] = acc;
            }
        }
        __syncthreads();
        if (wave < 4) {
            const int row = blk * 64 + 16 * wave + fr, sidx = row & (S - 1);
            f32x4 lg = PART[(wave * 8) * 64 + lane];
#pragma unroll
            for (int w = 1; w < 8; ++w) lg += PART[(wave * 8 + w) * 64 + lane];
            float mx = fmaxf(fmaxf(lg.x, lg.y), fmaxf(lg.z, lg.w));
            mx = fmaxf(mx, __shfl_xor(mx, 16)); mx = fmaxf(mx, __shfl_xor(mx, 32));
            f32x4 ev = (f32x4){expf(lg.x - mx), expf(lg.y - mx), expf(lg.z - mx), expf(lg.w - mx)};
            float den = (ev.x + ev.y) + (ev.z + ev.w);
            den += __shfl_xor(den, 16); den += __shfl_xor(den, 32);
#pragma unroll
            for (int i = 0; i < 4; ++i) aff[((size_t)b * NE + 4 * fq + i) * S + sidx] = ev[i] / den;
            *(int4*)(rank + (size_t)row * NE + 4 * fq) = make_int4(-1, -1, -1, -1);
        }
        __syncthreads();
    }
}
__device__ __forceinline__ void phase_topk(const MArgs& a, LAS unsigned char* lds, int pair, int tid, int lane, int wave) {
    const float* aff = (const float*)(a.ws + WS_AFF); int* idx = (int*)(a.ws + WS_IDX); float* val = (float*)(a.ws + WS_VAL); int* rank = (int*)(a.ws + WS_RANK);
    LAS unsigned* CNT = (LAS unsigned*)lds; LAS unsigned* TOT = CNT + 256;
    const int b = pair >> 4, e = pair & 15;
    const u32x4 kk = *(const u32x4*)(aff + (size_t)pair * S + 4 * tid);
    unsigned lo = 0u, hi = 0x3F800001u;
    for (int it = 0; hi - lo > 1u; ++it) {
        const unsigned step = (hi - lo + 15u) >> 4;
        unsigned mine = 0u;
#pragma unroll
        for (int i = 1; i < 16; ++i) {
            const unsigned p = min(lo + (unsigned)i * step, hi);
            const unsigned c = (unsigned)(__popcll(__ballot(kk.x >= p)) + __popcll(__ballot(kk.y >= p)) + __popcll(__ballot(kk.z >= p)) + __popcll(__ballot(kk.w >= p)));
            mine = (lane == i) ? c : mine;
        }
        LAS unsigned* buf = CNT + (it & 1) * 128;
        if (lane < 16) buf[wave * 16 + lane] = mine;
        __syncthreads();
        unsigned tot = 0u;
        if (lane < 16) {
#pragma unroll
            for (int w = 0; w < NWAVES; ++w) tot += buf[w * 16 + lane]; }
        const int i = __popcll(__ballot(lane >= 1 && lane < 16 && tot >= (unsigned)CAP));
        const unsigned nlo = lo + (unsigned)i * step, nhi = (i < 15) ? min(lo + (unsigned)(i + 1) * step, hi) : hi;
        lo = (unsigned)__builtin_amdgcn_readfirstlane((int)nlo); hi = (unsigned)__builtin_amdgcn_readfirstlane((int)nhi);
    }
    const unsigned T = lo;
    const unsigned pk = (unsigned)((kk.x > T) + (kk.y > T) + (kk.z > T) + (kk.w > T)) | ((unsigned)((kk.x == T) + (kk.y == T) + (kk.z == T) + (kk.w == T)) << 16);
    unsigned inc = pk;
#pragma unroll
    for (int d = 1; d < 64; d <<= 1) { const unsigned t = __shfl_up(inc, d); if (lane >= d) inc += t; }
    if (lane == 63) TOT[wave] = inc;
    __syncthreads();
    unsigned base = 0u, all = 0u;
#pragma unroll
    for (int w = 0; w < NWAVES; ++w) { const unsigned t = TOT[w]; all += t; base += (w < wave) ? t : 0u; }
    const unsigned total_g = all & 0xffffu, need_eq = (unsigned)CAP - total_g, excl = base + inc - pk;
    unsigned gpos = excl & 0xffffu, qpos = excl >> 16;
#pragma unroll
    for (int j = 0; j < 4; ++j) {
        const unsigned k = kk[j]; const int t = 4 * tid + j; int slot = -1;
        if (k > T) slot = (int)gpos++; else if (k == T) { if (qpos < need_eq) slot = (int)(total_g + qpos); ++qpos; }
        if (slot >= 0) { idx[pair * CAP + slot] = t; val[pair * CAP + slot] = __builtin_bit_cast(float, k); rank[((size_t)b * S + t) * NE + e] = slot; }
    }
    __syncthreads();
}
__device__ __forceinline__ float dot8s(f32x4 a, f32x4 b) { return (a.x * a.x + a.y * a.y + a.z * a.z + a.w * a.w) + (b.x * b.x + b.y * b.y + b.z * b.z + b.w * b.w); }
__device__ __forceinline__ void acc8_fp8(f32x4& a0, f32x4& a1, const u32x2 w) {
    typedef float f32x2v __attribute__((ext_vector_type(2)));
    const f32x2v p0 = __builtin_amdgcn_cvt_pk_f32_fp8((int)w.x, false), p1 = __builtin_amdgcn_cvt_pk_f32_fp8((int)w.x, true);
    const f32x2v p2 = __builtin_amdgcn_cvt_pk_f32_fp8((int)w.y, false), p3 = __builtin_amdgcn_cvt_pk_f32_fp8((int)w.y, true);
    a0.x += p0.x; a0.y += p0.y; a0.z += p1.x; a0.w += p1.y; a1.x += p2.x; a1.y += p2.y; a1.z += p3.x; a1.w += p3.y; }
__device__ __forceinline__ void phase_final(const MArgs& a, int gw, int NGW, int lane) {
    float* out = a.out; const unsigned char* Y = a.ws + WS_Y; const int* rank = (const int*)(a.ws + WS_RANK); const float* mod = (const float*)(a.ws + WS_MOD); const float* gf = a.in[20];
    for (int row = gw; row < M; row += NGW) {
        const int b = row >> 11;
        const float* gt = mod + (size_t)b * 6 * D + 5 * D;
        f32x4* xp = (f32x4*)(out + (size_t)row * D) + 2 * lane; const u32x4* x1p = (const u32x4*)((const bf16_t*)(a.ws + WS_X1) + (size_t)row * D) + lane;
        const int rk = (lane < NE) ? rank[(size_t)row * NE + lane] : -1;
        u32x4 xw[4];
#pragma unroll
        for (int j = 0; j < 4; ++j) xw[j] = x1p[64 * j];
        unsigned long long mask = __ballot(rk >= 0) & 0xffffull;
        f32x4 acc[4][2];
#pragma unroll
        for (int j = 0; j < 4; ++j) { acc[j][0] = (f32x4){0.f, 0.f, 0.f, 0.f}; acc[j][1] = (f32x4){0.f, 0.f, 0.f, 0.f}; }
        while (mask) {
            const int e0 = __builtin_ctzll(mask); mask &= mask - 1;
            const int e1 = mask ? __builtin_ctzll(mask) : -1; if (e1 >= 0) mask &= mask - 1;
            const int r0 = __builtin_amdgcn_readlane(rk, e0), r1 = (e1 >= 0) ? __builtin_amdgcn_readlane(rk, e1 >= 0 ? e1 : 0) : 0;
            const u32x2* y0 = (const u32x2*)(Y + ((size_t)(b * NE + e0) * CAP + r0) * D) + lane;
            const u32x2* y1 = (const u32x2*)(Y + ((size_t)(b * NE + (e1 >= 0 ? e1 : e0)) * CAP + (e1 >= 0 ? r1 : r0)) * D) + lane;
            u32x2 w0[4], w1[4];
#pragma unroll
            for (int j = 0; j < 4; ++j) w0[j] = y0[64 * j];
#pragma unroll
            for (int j = 0; j < 4; ++j) w1[j] = y1[64 * j];
#pragma unroll
            for (int j = 0; j < 4; ++j) acc8_fp8(acc[j][0], acc[j][1], w0[j]);
            if (e1 >= 0) {
#pragma unroll
                for (int j = 0; j < 4; ++j) acc8_fp8(acc[j][0], acc[j][1], w1[j]);
            }
        }
        float s = 0.f;
#pragma unroll
        for (int j = 0; j < 4; ++j) { const int d = 8 * (64 * j + lane);
            const f32x4 x0 = (f32x4){bflo(xw[j].x), bfhi(xw[j].x), bflo(xw[j].y), bfhi(xw[j].y)}, x1 = (f32x4){bflo(xw[j].z), bfhi(xw[j].z), bflo(xw[j].w), bfhi(xw[j].w)};
            acc[j][0] = x0 + *(const f32x4*)(gt + d) * (1.f / Y_SCALE) * acc[j][0]; acc[j][1] = x1 + *(const f32x4*)(gt + d + 4) * (1.f / Y_SCALE) * acc[j][1];
            s += dot8s(acc[j][0], acc[j][1]); }
        const float rstd = rsqrtf(wave_sum(s) * (1.f / D) + EPS);
#pragma unroll
        for (int j = 0; j < 4; ++j) { const int d = 8 * (64 * j + lane); xp[128 * j] = acc[j][0] * rstd * *(const f32x4*)(gf + d); xp[128 * j + 1] = acc[j][1] * rstd * *(const f32x4*)(gf + d + 4); }
    }
}

__device__ __forceinline__ int opaque_lane() { int t = threadIdx.x; asm volatile("" : "+v"(t)); return t & 63; }
enum { PH_MODP = 0, PH_XN, PH_GEMM1, PH_UP, PH_ATTN, PH_BR, PH_OUT, PH_ROUTER, PH_TOPK, PH_GATEUP, PH_DOWN, PH_FINAL, PH_N };
__global__ void __launch_bounds__(NTHR, 2) mega(MArgs args) {
    extern __shared__ __attribute__((aligned(16))) unsigned char lds_raw[];
    LAS unsigned char* lds = (LAS unsigned char*)lds_raw;
    volatile LAS unsigned* MISC = (volatile LAS unsigned*)(lds + MISC_OFF);
    const int tid = threadIdx.x, wave = __builtin_amdgcn_readfirstlane(tid >> 6);
#define lane opaque_lane()
    const int G = gridDim.x, bx = blockIdx.x, vcu = (G % 8 == 0) ? (bx % 8) * (G / 8) + bx / 8 : bx;
    const int gw = vcu * NWAVES + wave, NGW = G * NWAVES;
    unsigned char* ws = args.ws;
    for (int u = tid; u < (LDS_BYTES - MISC_OFF) / 4; u += NTHR) MISC[u] = 0u;
    __syncthreads();
    XcdBarrier bar = xcd_barrier_post((unsigned*)(ws + WS_CTL) + CW_BAR + args.li * XCD_BAR_WORDS, MISC + 8);
    const int lo = args.ph_lo, hi = args.ph_hi;
#define IN(k) (lo <= (k) && (k) < hi)
#define SEAM(k) do { if (IN(k) && IN((k) + 1)) xcd_barrier(bar); } while (0)

    if (IN(PH_MODP)) { phase_modp(args, lds, vcu, G, tid, lane, wave); } SEAM(PH_MODP);
    if (IN(PH_XN)) { phase_xn(args, lds, vcu, G, tid, lane, wave); } SEAM(PH_XN);
    if (IN(PH_GEMM1)) {
        pg::GridSched Sd; Sd.init(ws + WS_XN, ws + WS_WIN, D / 2, D / 2, M, IN_PAD, G, bx);
        pg::EpiIn E{(bf16_t*)(ws + WS_CQ), (bf16_t*)(ws + WS_CKV), ws + WS_KR, ws + WS_QG, ws + WS_KG, ws + WS_VTG, ws + WS_GA, ws + WS_GB,
                    (float*)(ws + WS_SSQCQ), (float*)(ws + WS_SSQKV), (const float*)(ws + WS_TAB), (const float*)(ws + WS_GP)};
        if (G == 256) Sd.r1 = 6;
        pg::gemm_phase<pg::EpiIn, pg::GridSched, false, true>(lds, D / 2, D / 2, Sd, E, nullptr);
    } SEAM(PH_GEMM1);
    if (IN(PH_UP)) {
        const bool deal = (G == 256); const int c2 = bx - 128;
        if (deal && bx < 128) {
            pg::GridSched Sd; Sd.init(ws + WS_XN, ws + WS_WIN, D / 2, D / 2, M, IN_PAD, G, bx); Sd.r0 = 6;
            pg::EpiGate E{ws + WS_GB, 18};
            pg::gemm_phase<pg::EpiGate, pg::GridSched, false, true>(lds, D / 2, D / 2, Sd, E, nullptr);
        }
        { pg::EpiUq E{ws + WS_QA, (const float*)(ws + WS_SSQCQ), (const float*)(ws + WS_TAB)};
          pg::ListSched Sd{(const char*)(ws + WS_CQ), (const char*)(ws + WS_WUQ), (size_t)256 * 512, (size_t)256 * 512, 6, deal ? c2 * 3 : bx, deal ? 1 : G, deal ? (bx < 128 ? 0 : 3) : (384 - bx + G - 1) / G};
          pg::gemm_phase<pg::EpiUq, pg::ListSched, false, true>(lds, 256, 256, Sd, E, nullptr); }
        { pg::EpiUkv E{ws + WS_KVA, (const float*)(ws + WS_SSQKV), ws + WS_VTA};
          pg::ListSched Sd{(const char*)(ws + WS_CKV), (const char*)(ws + WS_WUKV), (size_t)256 * 256, (size_t)256 * 256, 8, deal ? (bx < 128 ? bx * 3 : 384 + c2) : bx, deal ? 1 : G, deal ? (bx < 128 ? 3 : 1) : (512 - bx + G - 1) / G};
          pg::gemm_phase<pg::EpiUkv, pg::ListSched, false, true>(lds, 128, 128, Sd, E, nullptr); }
    } SEAM(PH_UP);
    if (IN(PH_ATTN)) {
        int cslot = 0; constexpr int NCSLOT = 4; const int cpos = (bx >> 3) % 4;
        for (int i = 0;; ++i) {
            if (i == cpos) for (; cslot < NCSLOT; ++cslot) phase_expert_conv(args, lds, gw, NGW, lane, wave, cslot, NCSLOT);
            const long L = (long)i * G + bx; if (L >= 1024) break;
            const int b = (int)(L & 7), q = (int)(L >> 3);
#ifndef ATT_SD_A
#define ATT_SD_A 2
#endif
#ifndef ATT_SD_B
#define ATT_SD_B 2
#endif
            if (q < 64) { const int h = q >> 3, qb = q & 7; const size_t r0 = (size_t)b * S;
                at::attn_unit<192, 1536, 1024, ATT_SD_A>(ws + WS_QA + (r0 + qb * 256) * 1536 + h * 192, ws + WS_KVA + r0 * 1024 + h * 128,
                    ws + WS_KR + r0 * 64, ws + WS_VTA + (size_t)(b * 8 + h) * 32 * 8192, ws + WS_OA + (r0 + qb * 256) * 1024 + h * 128, lds); }
            else { const int h = (q - 64) >> 3, qb = q & 7, kvh = h >> 2; const size_t r0 = (size_t)b * S;
                at::attn_unit<128, 1024, 256, ATT_SD_B>(ws + WS_QG + (r0 + qb * 256) * 1024 + h * 128, ws + WS_KG + r0 * 256 + kvh * 128,
                    nullptr, ws + WS_VTG + (size_t)(b * 2 + kvh) * 32 * 8192, ws + WS_OB + (r0 + qb * 256) * 1024 + h * 128, lds); }
        }
        for (; cslot < NCSLOT; ++cslot) phase_expert_conv(args, lds, gw, NGW, lane, wave, cslot, NCSLOT);
    } SEAM(PH_ATTN);
    if (IN(PH_BR)) {
        pg::PairSched Sd; Sd.g.init(ws + WS_OA, ws + WS_WBRA, 512, 512, M, D, G, bx); Sd.A1 = (const char*)(ws + WS_OB); Sd.B1 = (const char*)(ws + WS_WBRB);
        pg::EpiBr E{ws + WS_MRG8, ws + WS_GA, ws + WS_GB};
        pg::gemm_phase<pg::EpiBr, pg::PairSched, false, true>(lds, 512, 512, Sd, E, nullptr);
    } SEAM(PH_BR);
    if (IN(PH_OUT)) {
        pg::GridSched Sd; Sd.init(ws + WS_MRG8, ws + WS_WOUT, D / 2, D / 2, M, D, G, bx);
        pg::EpiOut E{args.in[0], (bf16_t*)(ws + WS_X1), (const float*)(ws + WS_MOD), (float*)(ws + WS_SSQX1)};
        pg::gemm_phase<pg::EpiOut, pg::GridSched, false, true>(lds, D / 2, D / 2, Sd, E, nullptr);
    } SEAM(PH_OUT);
    if (IN(PH_ROUTER)) { phase_router(args, lds, vcu, G, lane, tid, wave); } SEAM(PH_ROUTER);
    if (IN(PH_TOPK)) { for (int p = bx; p < NPAIR; p += G) phase_topk(args, lds, p, tid, lane, wave); } SEAM(PH_TOPK);
    if (IN(PH_GATEUP)) {
        pg::MoeSched Sd{(const char*)(ws + WS_H2), (const char*)(ws + WS_WGU), (size_t)S * D, (size_t)2048 * 2048, (size_t)256 * 2048, G, bx, true};
        pg::EpiGu E{(bf16_t*)(ws + WS_ACT)};
        pg::gemm_phase<pg::EpiGu, pg::MoeSched, true, true>(lds, D / 2, D / 2, Sd, E, (const int*)(ws + WS_IDX));
    } SEAM(PH_GATEUP);
    if (IN(PH_DOWN)) {
        pg::MoeSched Sd{(const char*)(ws + WS_ACT), (const char*)(ws + WS_WDN), (size_t)CAP * FF, (size_t)2048 * 1024, (size_t)256 * 1024, G, bx, false};
        pg::EpiDn E{ws + WS_Y, (const float*)(ws + WS_VAL)};
        pg::gemm_phase<pg::EpiDn, pg::MoeSched, false, true>(lds, FF / 2, FF / 2, Sd, E, nullptr);
    } SEAM(PH_DOWN);
    if (IN(PH_FINAL)) { phase_final(args, gw, NGW, lane); }
#undef IN
#undef SEAM
#undef lane
}


extern "C" void kernel_launch(void* const* d_in, const int* in_sizes, int n_in, void* d_out, int out_size, void* d_ws, size_t ws_size, hipStream_t stream) {
    static int ok = 0; static int grid = 0;
    if (ok == 0) {
        if (n_in != 21 || out_size != M * D || ws_size < WS_END) { fprintf(stderr, "kernel_launch: unexpected shapes n_in %d out %d ws %zu (need %zu)\n", n_in, out_size, ws_size, (size_t)WS_END); ok = -1; return; }
        if (hipFuncSetAttribute((const void*)mega, hipFuncAttributeMaxDynamicSharedMemorySize, LDS_BYTES) != hipSuccess) { fprintf(stderr, "kernel_launch: hipFuncSetAttribute(%d B LDS) failed\n", LDS_BYTES); ok = -1; return; }
        int dev = 0, cus = 0, per_cu = 0;
        if (hipGetDevice(&dev) != hipSuccess || hipDeviceGetAttribute(&cus, hipDeviceAttributeMultiprocessorCount, dev) != hipSuccess) { ok = -1; return; }
        if (hipOccupancyMaxActiveBlocksPerMultiprocessor(&per_cu, (const void*)mega, NTHR, LDS_BYTES) != hipSuccess || per_cu < 1) { fprintf(stderr, "kernel_launch: occupancy query says %d workgroups per CU\n", per_cu); (void)hipGetLastError(); ok = -1; return; }
        grid = cus;
        ok = 1;
    }
    if (ok < 0) return;
    (void)hipMemsetAsync((unsigned char*)d_ws + WS_CTL, 0, CTL_ZERO_BYTES, stream);
    MArgs ma{}; for (int i = 0; i < 21; ++i) ma.in[i] = (const float*)d_in[i]; ma.out = (float*)d_out; ma.ws = (unsigned char*)d_ws;
    ma.ph_lo = 0; ma.ph_hi = PH_N; ma.li = 0;
    hipLaunchKernelGGL(mega, dim3(grid), dim3(NTHR), LDS_BYTES, stream, ma);
}
```

```cpp
#include <hip/hip_runtime.h>
#include <stdint.h>
#include <cstdio>

constexpr int NB = 8, S = 2048, D = 2048, M = NB * S;
constexpr int NE = 16, CAP = 256, FF = 1024, NPAIR = NB * NE;
constexpr int IN_COLS = 6464;
constexpr int C_CQ = 0, C_CKV = 512, C_KR = 768, C_QG = 832, C_KG = 1856, C_VG = 2112, C_GA = 2368, C_GB = 4416;
constexpr float EPS = 1e-6f;
constexpr float LOG2E = 1.4426950408889634f;
constexpr float C2A = 0.07216878364870322f * LOG2E;
constexpr float C2B = 0.08838834764831845f * LOG2E;

typedef unsigned short bf16_t;
typedef float f32x4 __attribute__((ext_vector_type(4)));
typedef unsigned u32x4 __attribute__((ext_vector_type(4)));
typedef unsigned u32x2 __attribute__((ext_vector_type(2)));

__device__ __forceinline__ unsigned f2bf(float f) { unsigned u = __builtin_bit_cast(unsigned, f); return (u + 0x7fffu + ((u >> 16) & 1u)) >> 16; }
__device__ __forceinline__ unsigned pk2(float lo, float hi) { return f2bf(lo) | (f2bf(hi) << 16); }
__device__ __forceinline__ float bf2f(unsigned h) { return __builtin_bit_cast(float, h << 16); }
__device__ __forceinline__ float bflo(unsigned w) { return __builtin_bit_cast(float, w << 16); }
__device__ __forceinline__ float bfhi(unsigned w) { return __builtin_bit_cast(float, w & 0xffff0000u); }
__device__ __forceinline__ float wave_sum(float v) {
#pragma unroll
    for (int o = 1; o < 64; o <<= 1) v += __shfl_xor(v, o);
    return v;
}
__device__ __forceinline__ float wave_max(float v) {
#pragma unroll
    for (int o = 1; o < 64; o <<= 1) v = fmaxf(v, __shfl_xor(v, o));
    return v;
}

constexpr size_t MB = 1000000;
constexpr size_t al(size_t x) { return (x + 4095) / 4096 * 4096; }
constexpr size_t WS_CTL   = 0;
constexpr size_t WS_MOD   = 1u << 20;
constexpr size_t WS_TAB   = WS_MOD + al((size_t)NB * 6 * D * 4);
constexpr size_t WS_GP    = WS_TAB + al((size_t)2048 * 64 * 4);
constexpr size_t WS_SSQCQ = WS_GP + 4096;
constexpr size_t WS_SSQKV = WS_SSQCQ + al((size_t)M * 8 * 4);
constexpr size_t WS_SSQX1 = WS_SSQKV + al((size_t)M * 4 * 4);
constexpr size_t WS_AFF   = WS_SSQX1 + al((size_t)M * 32 * 4);
constexpr size_t WS_IDX   = WS_AFF + al((size_t)NPAIR * S * 4);
constexpr size_t WS_VAL   = WS_IDX + al((size_t)NPAIR * CAP * 4);
constexpr size_t WS_RANK  = WS_VAL + al((size_t)NPAIR * CAP * 4);
constexpr size_t WS_R1    = WS_RANK + al((size_t)M * 16 * 4);
constexpr size_t WS_R2    = WS_R1 + (size_t)M * D * 2;
constexpr size_t WS_R3    = WS_R2 + (size_t)M * D * 2;
constexpr size_t WS_CQ    = WS_R3 + (size_t)M * D * 2;
constexpr size_t WS_CKV   = WS_CQ + (size_t)M * 512 * 2;
constexpr size_t WS_KR    = WS_CKV + (size_t)M * 256 * 2;
constexpr size_t WS_QG    = WS_KR + (size_t)M * 64 * 2;
constexpr size_t WS_KG    = WS_QG + (size_t)M * 1024 * 2;
constexpr size_t WS_VG    = WS_KG + (size_t)M * 256 * 2;
constexpr size_t WS_QA    = WS_VG + (size_t)M * 256 * 2;
constexpr size_t WS_KVA   = WS_QA + (size_t)M * 1536 * 2;
constexpr size_t WS_OA    = WS_KVA + (size_t)M * 2048 * 2;
constexpr size_t WS_OB    = WS_OA + (size_t)M * 1024 * 2;
constexpr size_t WS_Y     = WS_CQ;
constexpr size_t WS_END0  = WS_OB + (size_t)M * 1024 * 2;
static_assert(WS_Y + (size_t)NPAIR * CAP * D * 2 <= WS_OA, "Y overlay");
constexpr size_t WS_MRG8 = WS_QA;
constexpr size_t WS_XN = WS_R1, WS_H2 = WS_R1, WS_GA = WS_R2, WS_ACT = WS_R2, WS_GB = WS_R3, WS_X1 = WS_R3;

__device__ __forceinline__ void sincos_d(double a, double& s, double& c) {
    const double q = rint(a * 0.63661977236758134308);
    double r = fma(-q, 1.57079632679489655800e+00, a);
    r = fma(-q, 6.12323399573676603587e-17, r);
    const double r2 = r * r;
    double sp = -1.0 / 1307674368000.0;
    sp = fma(sp, r2, 1.0 / 6227020800.0);
    sp = fma(sp, r2, -1.0 / 39916800.0);
    sp = fma(sp, r2, 1.0 / 362880.0);
    sp = fma(sp, r2, -1.0 / 5040.0);
    sp = fma(sp, r2, 1.0 / 120.0);
    sp = fma(sp, r2, -1.0 / 6.0);
    sp = fma(sp, r2, 1.0);
    const double sr = sp * r;
    double cp = 1.0 / 20922789888000.0;
    cp = fma(cp, r2, -1.0 / 87178291200.0);
    cp = fma(cp, r2, 1.0 / 479001600.0);
    cp = fma(cp, r2, -1.0 / 3628800.0);
    cp = fma(cp, r2, 1.0 / 40320.0);
    cp = fma(cp, r2, -1.0 / 720.0);
    cp = fma(cp, r2, 1.0 / 24.0);
    cp = fma(cp, r2, -0.5);
    cp = fma(cp, r2, 1.0);
    const int n = ((int)q) & 3;
    s = (n == 0) ? sr : (n == 1) ? cp : (n == 2) ? -sr : -cp;
    c = (n == 0) ? cp : (n == 1) ? -sr : (n == 2) ? -cp : sr;
}
__device__ __forceinline__ int perm_old_dim(int p) { const int blk = p & 64, q = p & 63; return blk + ((q & 1) ? (q >> 1) + 32 : (q >> 1)); }

#define LAS __attribute__((address_space(3)))
#define GAS __attribute__((address_space(1)))
typedef short bf16x8 __attribute__((ext_vector_type(8)));
typedef short s16x4 __attribute__((ext_vector_type(4)));
typedef float f32x16 __attribute__((ext_vector_type(16)));
typedef float f32x2 __attribute__((ext_vector_type(2)));

constexpr int IN_PAD = 6656;
constexpr size_t WS_WIN  = WS_END0;
constexpr size_t WS_WUQ  = WS_WIN  + (size_t)IN_PAD * D * 2;
constexpr size_t WS_WUKV = WS_WUQ  + (size_t)1536 * 512 * 2;
constexpr size_t WS_WBRA = WS_WUKV + (size_t)2048 * 256 * 2;
constexpr size_t WS_WBRB = WS_WBRA + (size_t)2048 * 1024 * 2;
constexpr size_t WS_WOUT = WS_WBRB + (size_t)2048 * 1024 * 2;
constexpr size_t WS_WGU  = WS_WOUT + (size_t)2048 * 2048 * 2;
constexpr size_t WS_WDN  = WS_WGU  + (size_t)NE * 2048 * 2048 * 2;
constexpr size_t WS_END  = WS_WDN  + (size_t)NE * 2048 * 1024 * 2;
constexpr size_t WS_MODP = WS_OA;
constexpr int MOD_SPLIT = 32;
static_assert((size_t)MOD_SPLIT * NB * 6 * D * 4 <= (size_t)M * 1024 * 2, "modp fits in OA");
static_assert(WS_END <= 729559040ull, "workspace budget");

constexpr int NWAVES = 8, NTHR = 512;
constexpr int RING_BYTES = 131072, EXCH_OFF = 131072, EXCH_BYTES = 8192, MISC_OFF = 160768  , LDS_BYTES = MISC_OFF + 256;
constexpr int CW_BAR = 256;
constexpr size_t CTL_ZERO_BYTES = 16384;

typedef __bf16 bf16x2_t __attribute__((ext_vector_type(2)));
__device__ __forceinline__ unsigned cvt_pk_bf16(float lo, float hi) { f32x2 v = {lo, hi}; bf16x2_t b = __builtin_convertvector(v, bf16x2_t); return __builtin_bit_cast(unsigned, b); }
__device__ __forceinline__ u32x4 pack8(f32x4 a, f32x4 b) { u32x4 w; w.x = cvt_pk_bf16(a.x, a.y); w.y = cvt_pk_bf16(a.z, a.w); w.z = cvt_pk_bf16(b.x, b.y); w.w = cvt_pk_bf16(b.z, b.w); return w; }
constexpr float QS = 16.f;
constexpr size_t WS_VTG = WS_VG;
constexpr size_t WS_VTA = WS_R3 + (size_t)M * D;
__device__ __forceinline__ u32x2 pack8_fp8(f32x4 a, f32x4 b);
__device__ __forceinline__ int vpos(int kk) { return 32 * ((kk >> 2) & 1) + 4 * (kk >> 3) + (kk & 3); }
__device__ __forceinline__ unsigned quad_tr4(unsigned w, int a) {
    const unsigned x0 = (unsigned)__builtin_amdgcn_mov_dpp((int)w, 0x00, 0xf, 0xf, true), x1 = (unsigned)__builtin_amdgcn_mov_dpp((int)w, 0x55, 0xf, 0xf, true);
    const unsigned x2 = (unsigned)__builtin_amdgcn_mov_dpp((int)w, 0xaa, 0xf, 0xf, true), x3 = (unsigned)__builtin_amdgcn_mov_dpp((int)w, 0xff, 0xf, 0xf, true);
    const int sh = 8 * a;
    return ((x0 >> sh) & 0xffu) | (((x1 >> sh) & 0xffu) << 8) | (((x2 >> sh) & 0xffu) << 16) | (((x3 >> sh) & 0xffu) << 24); }
__device__ __forceinline__ unsigned char fp8_byte(float v) { return (unsigned char)(__builtin_amdgcn_cvt_pk_fp8_f32(v, v, 0, false) & 0xffu); }
constexpr float W8_SCALE = 64.f;
constexpr float Y_SCALE = 16.f;
__device__ __forceinline__ unsigned pk4_fp8(float a, float b, float c, float d) { unsigned w = __builtin_amdgcn_cvt_pk_fp8_f32(a, b, 0, false); return __builtin_amdgcn_cvt_pk_fp8_f32(c, d, w, true); }
__device__ __forceinline__ u32x2 pack8_fp8(f32x4 a, f32x4 b) { u32x2 w; w.x = pk4_fp8(a.x, a.y, a.z, a.w); w.y = pk4_fp8(b.x, b.y, b.z, b.w); return w; }
__device__ __forceinline__ unsigned pk4_u8(float a, float b, float c, float d) {
    unsigned r = __builtin_amdgcn_cvt_pk_u8_f32(__builtin_rintf(a * 255.f), 0, 0u); r = __builtin_amdgcn_cvt_pk_u8_f32(__builtin_rintf(b * 255.f), 1, r);
    r = __builtin_amdgcn_cvt_pk_u8_f32(__builtin_rintf(c * 255.f), 2, r); return __builtin_amdgcn_cvt_pk_u8_f32(__builtin_rintf(d * 255.f), 3, r); }
__device__ __forceinline__ float ub0(unsigned w) { return (float)(w & 0xffu); }
__device__ __forceinline__ float ub1(unsigned w) { return (float)((w >> 8) & 0xffu); }
__device__ __forceinline__ float ub2(unsigned w) { return (float)((w >> 16) & 0xffu); }
__device__ __forceinline__ float ub3(unsigned w) { return (float)(w >> 24); }
__device__ __forceinline__ float sigmoidf_fast(float v) { return __builtin_amdgcn_rcpf(1.f + __builtin_amdgcn_exp2f(-v * LOG2E)); }

#define XB_TMO      128
#define XB_XCNT(j)  (256  + 64 * (j))
#define XB_XSUB(j)  (1280 + 64 * (j))
#define XB_XGEN(j)  (2304 + 64 * (j))
#define XB_TOP      3328
#define XB_TOPGEN   3392
#define XCD_BAR_WORDS 3456
#define XB_SPIN_CAP (1u << 18)
__device__ __forceinline__ unsigned xb_ld(unsigned* p)              { return __hip_atomic_load(p, __ATOMIC_RELAXED, __HIP_MEMORY_SCOPE_AGENT); }
__device__ __forceinline__ unsigned xb_add(unsigned* p, unsigned v) { return __hip_atomic_fetch_add(p, v, __ATOMIC_RELAXED, __HIP_MEMORY_SCOPE_AGENT); }
__device__ __forceinline__ unsigned xb_add_l2(unsigned* p, unsigned v) { return __hip_atomic_fetch_add(p, v, __ATOMIC_RELAXED, __HIP_MEMORY_SCOPE_WORKGROUP); }
__device__ __forceinline__ unsigned xb_poll_l2(unsigned* p) { unsigned r; const unsigned z = 0u;
    asm volatile("global_atomic_or %0, %1, %2, off sc0\n\ts_waitcnt vmcnt(0)" : "=&v"(r) : "v"(p), "v"(z) : "memory"); return r; }
__device__ __forceinline__ unsigned xb_xcc_id() { return (unsigned)__builtin_amdgcn_s_getreg((3 << 11) | 20) & 0xFu; }
#define XB_SPIN(cond, bar) do { unsigned _sp = 0; while (cond) { __builtin_amdgcn_s_sleep(1); \
    if ((++_sp & 255u) == 0u) { if (xb_ld(&(bar)[XB_TMO])) break; if (_sp > XB_SPIN_CAP) { atomicAdd(&(bar)[XB_TMO], 1u); break; } } } } while (0)
struct XcdBarrier { unsigned* bar; unsigned x; volatile LAS unsigned* st; };
__device__ __forceinline__ XcdBarrier xcd_barrier_post(unsigned* bar, volatile LAS unsigned* st) {
    XcdBarrier b; b.bar = bar; b.x = xb_xcc_id(); b.st = st;
    if (threadIdx.x == 0) (void)xb_add(&bar[XB_XCNT(b.x)], 1u);
    return b;
}
__device__ __forceinline__ void xcd_barrier_complete(unsigned* bar, unsigned x, unsigned& nloc, unsigned& nx) {
    const unsigned G = gridDim.x * gridDim.y * gridDim.z;
    unsigned sum, cnt, mine, sp = 0u;
    for (;;) {
        sum = 0u; cnt = 0u; mine = 0u;
#pragma unroll
        for (unsigned j = 0; j < 16; ++j) { const unsigned c = xb_ld(&bar[XB_XCNT(j)]); sum += c; cnt += (c > 0u) ? 1u : 0u; mine = (j == x) ? c : mine; }
        if (sum == G) break;
        __builtin_amdgcn_s_sleep(1);
        if ((++sp & 255u) == 0u) { if (xb_ld(&bar[XB_TMO])) break; if (sp > XB_SPIN_CAP) { atomicAdd(&bar[XB_TMO], 1u); break; } }
    }
    nloc = mine > 0u ? mine : 1u; nx = cnt > 0u ? cnt : 1u;
}
__device__ __forceinline__ void xcd_barrier(const XcdBarrier& b) {
    asm volatile("s_waitcnt vmcnt(0)" ::: "memory");
    __syncthreads();
    if (threadIdx.x == 0) {
        unsigned* bar = b.bar;
        __builtin_amdgcn_s_waitcnt(0);
        unsigned nloc = b.st[0], nx = b.st[1];
        if (nloc == 0u) { xcd_barrier_complete(bar, b.x, nloc, nx); b.st[0] = nloc; b.st[1] = nx; }
        const unsigned old = xb_add_l2(&bar[XB_XSUB(b.x)], 1u);
        const unsigned gen = old / nloc;
        if (old + 1u == (gen + 1u) * nloc) {
            __builtin_amdgcn_fence(__ATOMIC_RELEASE, "agent");
            asm volatile("s_waitcnt vmcnt(0)" ::: "memory");
            const unsigned og = xb_add(&bar[XB_TOP], 1u);
            const unsigned tg = og / nx;
            if (og + 1u == (tg + 1u) * nx) xb_add(&bar[XB_TOPGEN], 1u);
            else XB_SPIN(xb_ld(&bar[XB_TOPGEN]) == tg, bar);
            xb_add_l2(&bar[XB_XGEN(b.x)], 1u);
            __builtin_amdgcn_fence(__ATOMIC_ACQUIRE, "agent");
            asm volatile("s_waitcnt vmcnt(0)" ::: "memory");
        } else {
            XB_SPIN(xb_poll_l2(&bar[XB_XGEN(b.x)]) == gen, bar);
            __builtin_amdgcn_fence(__ATOMIC_ACQUIRE, "agent");
            asm volatile("s_waitcnt vmcnt(0)" ::: "memory");
        }
    }
    __syncthreads();
}

namespace pg {
constexpr int BM = 256, BK = 64, HALF = 128, HTB = HALF * BK * 2, NXCD = 8, WGM = 4;
__device__ __forceinline__ int lds_byte(int r, int c) { const int st = (r >> 4) * 2 + (c >> 5), rr = r & 15, cc = c & 31, ob = rr * 64 + cc * 2; return st * 1024 + (ob ^ (((ob >> 9) & 1) << 5)); }
__device__ __forceinline__ void stage_rc(int b, int& R, int& C) { const int st = b / 1024, sb = b % 1024, swz = sb ^ (((sb >> 9) & 1) << 5); R = (st >> 1) * 16 + swz / 64; C = (st & 1) * 32 + (swz % 64) / 2; }
__device__ __forceinline__ int perm32(int rho) { const int n = rho >> 4, i = rho & 15; return 8 * (i >> 2) + 4 * n + (i & 3); }

struct Unit { const char* A; const char* B; int pm, pn, aux, pad; };
typedef int v8i __attribute__((ext_vector_type(8))); typedef int v4i __attribute__((ext_vector_type(4)));
__device__ __forceinline__ void mfma_f8(f32x4& c, const v8i w, const v8i x, const int scale_w, const int scale_x) {
    asm volatile("v_mfma_scale_f32_16x16x128_f8f6f4 %0, %1, %2, %0, %3, %4 op_sel_hi:[0,0,0]" : "+v"(c) : "v"(w), "v"(x), "v"(scale_w), "v"(scale_x)); }
__device__ __forceinline__ v8i cat8(bf16x8 lo, bf16x8 hi) { const v4i a = __builtin_bit_cast(v4i, lo), b = __builtin_bit_cast(v4i, hi); return __builtin_shufflevector(a, b, 0, 1, 2, 3, 4, 5, 6, 7); }
typedef f32x4 Acc[2][2][4][2];

struct GridSched {
    const char* A; const char* B; size_t at, bt; int nM, nN, nwg, G, c; int r0 = 0, r1 = 1 << 20;
    __device__ __forceinline__ void init(const void* A_, const void* B_, int lda, int K, int Mr, int N, int G_, int c_) {
        A = (const char*)A_; B = (const char*)B_; at = (size_t)BM * lda * 2; bt = (size_t)BM * K * 2; nM = Mr / BM; nN = N / BM; nwg = nM * nN; G = G_; c = c_; }
    __device__ __forceinline__ void tile(long L, int& pm, int& pn) const {
        int wgid = (int)L; { const int q = nwg / NXCD, r = nwg % NXCD, xcd = wgid % NXCD, off = wgid / NXCD; wgid = (xcd < r ? xcd * (q + 1) : r * (q + 1) + (xcd - r) * q) + off; }
        const int nig = WGM * nN, gid = wgid / nig, fm = gid * WGM, gsz = (nM - fm) < WGM ? (nM - fm) : WGM;
        pm = fm + ((wgid % nig) % gsz); pn = (wgid % nig) / gsz; }
    __device__ __forceinline__ bool next(int i, Unit& u) const {
        if (i + r0 >= r1) return false;
        const long L = (long)(i + r0) * G + c; if (L >= nwg) return false;
        tile(L, u.pm, u.pn); u.A = A + (size_t)u.pm * at; u.B = B + (size_t)u.pn * bt; u.aux = 0; return true; }
};
struct ListSched {
    const char* A; const char* B; size_t at, bt; int nN, first, stride, count;
    __device__ __forceinline__ bool next(int i, Unit& u) const {
        if (i >= count) return false; const int t = first + i * stride; u.pm = t / nN; u.pn = t - u.pm * nN;
        u.A = A + (size_t)u.pm * at; u.B = B + (size_t)u.pn * bt; u.aux = 0; return true; }
};
struct PairSched {
    GridSched g; const char* A1; const char* B1;
    __device__ __forceinline__ bool next(int i, Unit& u) const {
        const long L = (long)(i >> 1) * g.G + g.c; if (L >= g.nwg) return false;
        g.tile(L, u.pm, u.pn); const int w = i & 1;
        u.A = (w ? A1 : g.A) + (size_t)u.pm * g.at; u.B = (w ? B1 : g.B) + (size_t)u.pn * g.bt; u.aux = w; return true; }
};
struct MoeSched {
    const char* A; const char* B; size_t a_pair, b_exp, b_tile; int G, c; bool gather;
    __device__ __forceinline__ bool next(int i, Unit& u) const {
        const long L = (long)i * G + c; if (L >= NPAIR * 8) return false;
        const int x = (int)(L & 7), q = (int)(L >> 3), e = 2 * x + (q >> 6), r = q & 63, b = r >> 3, nt = r & 7;
        u.pm = b * NE + e; u.pn = nt; u.aux = b * NE + e;
        u.A = A + (gather ? (size_t)b * a_pair : (size_t)u.pm * a_pair); u.B = B + (size_t)e * b_exp + (size_t)nt * b_tile; return true; }
};

template <class Epi, class Sched, bool GATHER, bool F8 = false>
__device__ __forceinline__ void gemm_phase(LAS unsigned char* lds, const unsigned char* wsbase, const int K, const int lda, const Sched& S, const Epi& E, const int* __restrict__ gidx) {
    const int tid = threadIdx.x, wid = __builtin_amdgcn_readfirstlane(tid >> 6), lane = tid & 63, wr = wid >> 2, wc = wid & 3, fr = lane & 15, fq = lane >> 4;
    int nt_ = K / BK; asm volatile("" : "+s"(nt_)); const int nt = nt_;
    unsigned voffA[2], voffB[2]; int RA[2], CA2[2];
#pragma unroll
    for (int i = 0; i < 2; ++i) { int R, C; stage_rc(tid * 16 + i * 8192, R, C); const int Rb = Epi::PERM ? ((R & ~31) + perm32(R & 31)) : R;
        RA[i] = R; CA2[i] = C * 2; voffA[i] = (unsigned)(R * lda + C) * 2u; voffB[i] = (unsigned)(Rb * K + C) * 2u; }
    const size_t kstep = (size_t)(BK * 2);
    const size_t hstepA = GATHER ? 0 : (size_t)HALF * lda * 2, hstepB = (size_t)HALF * K * 2;
    const unsigned ldsw = (unsigned)wid * 1024u;
    const int aoff = lds_byte(wr * 64 + fr, fq * 8), boff = lds_byte(wc * 32 + fr, fq * 8);
    unsigned vAc[2][2], vAn[2][2];
    int sc1 = 0x7F7F7F7F, scw = 0x79797979; asm volatile("" : "+v"(sc1), "+v"(scw));
#define PG_SA(b, h) (((b) * 2 + (h)) * HTB)
#define PG_SB(b, h) ((4 + (b) * 2 + (h)) * HTB)
    const __amdgpu_buffer_rsrc_t rsrc = __builtin_amdgcn_make_buffer_rsrc((void*)wsbase, 0, 0x7fffffff, 0x00020000);
#define PG_GLDS(bufoff, gp, v0, v1) do { const unsigned so_ = (unsigned)((const unsigned char*)(gp) - wsbase); \
        __builtin_amdgcn_raw_ptr_buffer_load_lds(rsrc, (LAS unsigned*)(lds + (bufoff) + ldsw), 16, (int)(v0), (int)so_, 0, 0); \
        __builtin_amdgcn_raw_ptr_buffer_load_lds(rsrc, (LAS unsigned*)(lds + (bufoff) + ldsw + 8192), 16, (int)(v1), (int)so_, 0, 0); } while (0)
#define PG_STAGE_B(bufoff, gp) PG_GLDS(bufoff, gp, voffB[0], voffB[1])
#define PG_STAGE_A(bufoff, gp, h, usen) do { if constexpr (GATHER) { const unsigned _v0 = (usen) ? vAn[h][0] : vAc[h][0], _v1 = (usen) ? vAn[h][1] : vAc[h][1]; PG_GLDS(bufoff, gp, _v0, _v1); } \
        else { PG_GLDS(bufoff, (gp) + (h) * hstepA, voffA[0], voffA[1]); } } while (0)
#define PG_LDA(dst, b, h) do { _Pragma("unroll") for (int m = 0; m < 4; ++m) _Pragma("unroll") for (int k = 0; k < 2; ++k) dst[m][k] = *(const LAS bf16x8*)(lds + PG_SA(b, h) + aoff + m * 2048 + k * 1024); } while (0)
#define PG_LDB(dst, b, h) do { _Pragma("unroll") for (int n = 0; n < 2; ++n) _Pragma("unroll") for (int k = 0; k < 2; ++k) dst[n][k] = *(const LAS bf16x8*)(lds + PG_SB(b, h) + boff + n * 2048 + k * 1024); } while (0)
#define PG_MMA(ai, bj, At, Bt) do { __builtin_amdgcn_s_setprio(1); _Pragma("unroll") for (int m = 0; m < 4; ++m) _Pragma("unroll") for (int n = 0; n < 2; ++n) { \
        if constexpr (F8) mfma_f8(acc[ai][bj][m][n], cat8(Bt[n][0], Bt[n][1]), cat8(At[m][0], At[m][1]), scw, sc1); \
        else { _Pragma("unroll") for (int k = 0; k < 2; ++k) acc[ai][bj][m][n] = __builtin_amdgcn_mfma_f32_16x16x32_bf16(Bt[n][k], At[m][k], acc[ai][bj][m][n], 0, 0, 0); } } \
        __builtin_amdgcn_s_setprio(0); } while (0)
#ifdef DRAIN_ALL
#define PG_WAIT_V(n) asm volatile("s_waitcnt vmcnt(0)" ::: "memory")
#else
#define PG_WAIT_V(n) asm volatile("s_waitcnt vmcnt(" #n ")" ::: "memory")
#endif
#define PG_WAIT_L(n) asm volatile("s_waitcnt lgkmcnt(" #n ")" ::: "memory")
#define PG_BAR __builtin_amdgcn_s_barrier()
#define PG_SCHED __builtin_amdgcn_sched_barrier(0)
    Unit cur, nxt; int ui = 0;
    if (!S.next(0, cur)) return;
    if constexpr (GATHER) {
#pragma unroll
        for (int h = 0; h < 2; ++h)
#pragma unroll
            for (int i = 0; i < 2; ++i) vAc[h][i] = (unsigned)(gidx[cur.aux * CAP + h * HALF + RA[i]] * lda * 2 + CA2[i]);
    }
    Acc acc;
#pragma unroll
    for (int a = 0; a < 2; ++a)
#pragma unroll
        for (int b = 0; b < 2; ++b)
#pragma unroll
            for (int m = 0; m < 4; ++m)
#pragma unroll
                for (int n = 0; n < 2; ++n) acc[a][b][m][n] = (f32x4){0.f, 0.f, 0.f, 0.f};
    bf16x8 At[4][2], B0[2][2], B1[2][2];
    const char* cA = cur.A; const char* cB = cur.B;
    PG_STAGE_B(PG_SB(0, 0), cB); PG_STAGE_B(PG_SB(0, 1), cB + hstepB); PG_STAGE_A(PG_SA(0, 0), cA, 0, false); PG_STAGE_A(PG_SA(0, 1), cA, 1, false);
    if (wr == 1) PG_BAR;
    PG_WAIT_V(2); PG_BAR;
    PG_STAGE_B(PG_SB(1, 0), cB + kstep); PG_STAGE_A(PG_SA(1, 0), cA + kstep, 0, false); PG_STAGE_B(PG_SB(1, 1), cB + hstepB + kstep);
    PG_WAIT_V(6); PG_BAR;
    for (;;) {
        const bool has_next = S.next(ui + 1, nxt);
        if constexpr (GATHER) {
            if (has_next) {
#pragma unroll
                for (int h = 0; h < 2; ++h)
#pragma unroll
                    for (int i = 0; i < 2; ++i) vAn[h][i] = (unsigned)(gidx[nxt.aux * CAP + h * HALF + RA[i]] * lda * 2 + CA2[i]);
            } else {
#pragma unroll
                for (int h = 0; h < 2; ++h)
#pragma unroll
                    for (int i = 0; i < 2; ++i) vAn[h][i] = vAc[h][i];
            }
        }
        const char* nA = has_next ? nxt.A : cA; const char* nB = has_next ? nxt.B : cB;
        for (int t = 0; t < nt; t += 2) {
            const bool last = (t == nt - 2);
            const char* a1 = cA + (size_t)(t + 1) * kstep;
            const char* a2 = last ? nA : cA + (size_t)(t + 2) * kstep; const char* b2 = last ? nB : cB + (size_t)(t + 2) * kstep;
            const char* a3 = a2 + kstep; const char* b3 = b2 + kstep;
            PG_LDB(B0, 0, 0); PG_LDB(B1, 0, 1); PG_SCHED; PG_LDA(At, 0, 0); PG_STAGE_A(PG_SA(1, 1), a1, 1, false);
            PG_WAIT_V(8); PG_WAIT_L(0); PG_BAR; PG_MMA(0, 0, At, B0); PG_MMA(0, 1, At, B1); PG_BAR; PG_SCHED;
            PG_LDA(At, 0, 1); PG_STAGE_B(PG_SB(0, 0), b2); PG_STAGE_B(PG_SB(0, 1), b2 + hstepB); PG_STAGE_A(PG_SA(0, 0), a2, 0, last);
            PG_WAIT_V(8); PG_WAIT_L(0); PG_BAR; PG_MMA(1, 0, At, B0); PG_MMA(1, 1, At, B1); PG_BAR; PG_SCHED;
            PG_LDB(B0, 1, 0); PG_LDB(B1, 1, 1); PG_SCHED; PG_LDA(At, 1, 0); PG_STAGE_A(PG_SA(0, 1), a2, 1, last);
            PG_WAIT_V(8); PG_WAIT_L(0); PG_BAR; PG_MMA(0, 0, At, B0); PG_MMA(0, 1, At, B1); PG_BAR; PG_SCHED;
            PG_LDA(At, 1, 1); PG_STAGE_B(PG_SB(1, 0), b3); PG_STAGE_B(PG_SB(1, 1), b3 + hstepB); PG_STAGE_A(PG_SA(1, 0), a3, 0, last);
            PG_WAIT_V(8); PG_WAIT_L(0); PG_BAR; PG_MMA(1, 0, At, B0); PG_MMA(1, 1, At, B1); PG_BAR; PG_SCHED;
        }
        if constexpr (F8) asm volatile("s_nop 15\n\ts_nop 7" ::: "memory");
        if (wr == 0) PG_BAR;
        E(acc, cur, wr, wc, fr, fq, lds);
        if (!has_next) break;
        if (!(Epi::KEEP && cur.aux == 0)) {
#pragma unroll
            for (int a = 0; a < 2; ++a)
#pragma unroll
                for (int b = 0; b < 2; ++b)
#pragma unroll
                    for (int m = 0; m < 4; ++m)
#pragma unroll
                        for (int n = 0; n < 2; ++n) acc[a][b][m][n] = (f32x4){0.f, 0.f, 0.f, 0.f};
        }
        cur = nxt; cA = nA; cB = nB; ++ui;
        if constexpr (GATHER) {
#pragma unroll
            for (int h = 0; h < 2; ++h)
#pragma unroll
                for (int i = 0; i < 2; ++i) vAc[h][i] = vAn[h][i];
        }
        if (wr == 1) PG_BAR;
    }
    PG_WAIT_V(0);
    PG_BAR;
#undef PG_SA
#undef PG_SB
#undef PG_GLDS
#undef PG_STAGE_A
#undef PG_STAGE_B
#undef PG_LDA
#undef PG_LDB
#undef PG_MMA
}

#define ST16(p, v) do { *(u32x4*)(p) = (v); } while (0)
__device__ __forceinline__ void rope8(f32x4& v0, f32x4& v1, const f32x4 cs0, const f32x4 cs1) {
    const f32x4 a = v0, b = v1;
    v0.x = a.x * cs0.x - a.y * cs0.y; v0.y = a.x * cs0.y + a.y * cs0.x; v0.z = a.z * cs0.z - a.w * cs0.w; v0.w = a.z * cs0.w + a.w * cs0.z;
    v1.x = b.x * cs1.x - b.y * cs1.y; v1.y = b.x * cs1.y + b.y * cs1.x; v1.z = b.z * cs1.z - b.w * cs1.w; v1.w = b.z * cs1.w + b.w * cs1.z;
}
__device__ __forceinline__ float dot8(f32x4 a, f32x4 b) { return (a.x * a.x + a.y * a.y) + (a.z * a.z + a.w * a.w) + (b.x * b.x + b.y * b.y) + (b.z * b.z + b.w * b.w); }

struct EpiIn {
    static constexpr bool PERM = true; static constexpr bool KEEP = false;
    bf16_t *CQ, *CKV; unsigned char *KR, *QG, *KG;
    unsigned char* VT; unsigned char *GA, *GB; float *ssq_cq, *ssq_kv; const float* tab; const float* gp;
    __device__ __forceinline__ void operator()(const Acc& acc, const Unit& u, int wr, int wc, int fr, int fq, LAS unsigned char* lds) const {
        int fro = fr; asm volatile("" : "+v"(fro)); int fqo = fq; asm volatile("" : "+v"(fqo));
        const int pn = u.pn, row0 = u.pm * BM + wr * 64 + fro, cw = wc * 32 + 8 * fq, cwo = wc * 32 + 8 * fqo;
        if (pn <= 2) {
            unsigned char* O = (unsigned char*)(pn < 2 ? CQ : CKV); const int ld = pn < 2 ? 512 : 256, c0 = pn < 2 ? pn * 256 : 0;
            float* sq = pn < 2 ? ssq_cq : ssq_kv; const int ns = pn < 2 ? 8 : 4, s0 = pn < 2 ? pn * 4 : 0;
#pragma unroll
            for (int ai = 0; ai < 2; ++ai)
#pragma unroll
                for (int m = 0; m < 4; ++m) { const int row = row0 + ai * HALF + m * 16; float s = 0.f;
#pragma unroll
                    for (int bj = 0; bj < 2; ++bj) { const f32x4 v0 = acc[ai][bj][m][0], v1 = acc[ai][bj][m][1]; s += dot8(v0, v1);
                        *(u32x2*)(O + (size_t)row * ld + c0 + bj * HALF + cwo) = pack8_fp8(v0, v1); }
                    s += __shfl_xor(s, 16); s += __shfl_xor(s, 32);
                    if (fqo == 0) sq[(size_t)row * ns + s0 + wc] = s; }
        } else if (pn == 3) {
            if (wc < 2) {
#pragma unroll
                for (int ai = 0; ai < 2; ++ai) { f32x4 cs[4][2];
#pragma unroll
                    for (int m = 0; m < 4; ++m) { const int s = (row0 + ai * HALF + m * 16) & (S - 1); const f32x4* tp = (const f32x4*)(tab + (size_t)(s * 32 + 16 * wc + 4 * fqo) * 2); cs[m][0] = tp[0]; cs[m][1] = tp[1]; }
#pragma unroll
                    for (int m = 0; m < 4; ++m) { const int row = row0 + ai * HALF + m * 16;
                        f32x4 v0 = acc[ai][0][m][0], v1 = acc[ai][0][m][1]; rope8(v0, v1, cs[m][0], cs[m][1]);
                        *(u32x2*)(KR + (size_t)row * 64 + cwo) = pack8_fp8(v0, v1); } }
            }
        } else if (pn <= 8) {
            const bool isk = (pn == 8);
            LAS float* X = (LAS float*)(lds + EXCH_OFF);
            const f32x4 g0 = *(const f32x4*)(gp + (isk ? 128 : 0) + cwo), g1 = *(const f32x4*)(gp + (isk ? 128 : 0) + cwo + 4);
#pragma unroll
            for (int ai = 0; ai < 2; ++ai)
#pragma unroll
                for (int m = 0; m < 4; ++m)
#pragma unroll
                    for (int bj = 0; bj < 2; ++bj) { float s = dot8(acc[ai][bj][m][0], acc[ai][bj][m][1]); s += __shfl_xor(s, 16); s += __shfl_xor(s, 32);
                        if (fqo == 0) X[((ai * HALF + wr * 64 + m * 16 + fro) * 2 + bj) * 4 + wc] = s; }
            asm volatile("s_waitcnt lgkmcnt(0)" ::: "memory"); __builtin_amdgcn_s_barrier(); asm volatile("" ::: "memory");
            const float scale = isk ? 1.0f : C2B * QS;
            unsigned char* O = isk ? KG : QG; const int ld = isk ? 256 : 1024, c0 = isk ? 0 : (pn - 4) * 256;
#pragma unroll
            for (int ai = 0; ai < 2; ++ai) { f32x4 cs[4][2];
#pragma unroll
                for (int m = 0; m < 4; ++m) { const int s = (row0 + ai * HALF + m * 16) & (S - 1), pos = (wc < 2) ? (s >> 6) : (s & 63);
                    const f32x4* tp = (const f32x4*)(tab + (size_t)(pos * 32 + 16 * (wc & 1) + 4 * fqo) * 2); cs[m][0] = tp[0]; cs[m][1] = tp[1]; }
#pragma unroll
                for (int m = 0; m < 4; ++m) { const int rl = ai * HALF + wr * 64 + m * 16 + fro, row = u.pm * BM + rl;
#pragma unroll
                    for (int bj = 0; bj < 2; ++bj) { const f32x4 pp = *(const LAS f32x4*)(X + (rl * 2 + bj) * 4);
                        const float rstd = rsqrtf(((pp.x + pp.y) + (pp.z + pp.w)) * (1.f / 128.f) + EPS) * scale;
                        f32x4 v0 = acc[ai][bj][m][0] * rstd * g0, v1 = acc[ai][bj][m][1] * rstd * g1; rope8(v0, v1, cs[m][0], cs[m][1]);
                        *(u32x2*)(O + (size_t)row * ld + c0 + bj * HALF + cwo) = pack8_fp8(v0, v1); } } }
        } else if (pn == 9) {
#pragma unroll
            for (int ai = 0; ai < 2; ++ai)
#pragma unroll
                for (int m = 0; m < 4; ++m) { const int row = row0 + ai * HALF + m * 16, b = row >> 11, sq = row & (S - 1), t = sq >> 6, kp = vpos(sq & 60);
#pragma unroll
                    for (int bj = 0; bj < 2; ++bj) { unsigned char* img = VT + ((size_t)((b * 2 + bj) * 32 + t) * 128 + cwo + (fro & 3)) * 64 + kp;
#pragma unroll
                        for (int n = 0; n < 2; ++n) { const f32x4 v = acc[ai][bj][m][n]; *(unsigned*)(img + 4 * n * 64) = quad_tr4(pk4_fp8(v.x, v.y, v.z, v.w), fro & 3); } } }
        } else {
            unsigned char* O = pn < 18 ? GA : GB; const int c0 = (pn < 18 ? pn - 10 : pn - 18) * 256;
#pragma unroll
            for (int ai = 0; ai < 2; ++ai)
#pragma unroll
                for (int m = 0; m < 4; ++m) { const int row = row0 + ai * HALF + m * 16;
#pragma unroll
                    for (int bj = 0; bj < 2; ++bj) { f32x4 v0 = acc[ai][bj][m][0], v1 = acc[ai][bj][m][1];
                        v0.x = sigmoidf_fast(v0.x); v0.y = sigmoidf_fast(v0.y); v0.z = sigmoidf_fast(v0.z); v0.w = sigmoidf_fast(v0.w);
                        v1.x = sigmoidf_fast(v1.x); v1.y = sigmoidf_fast(v1.y); v1.z = sigmoidf_fast(v1.z); v1.w = sigmoidf_fast(v1.w);
                        u32x2 w8; w8.x = pk4_u8(v0.x, v0.y, v0.z, v0.w); w8.y = pk4_u8(v1.x, v1.y, v1.z, v1.w);
                        *(u32x2*)(O + (size_t)row * D + c0 + bj * HALF + cwo) = w8; } }
        }
    }
};
struct EpiGate {
    static constexpr bool PERM = true; static constexpr bool KEEP = false;
    unsigned char* O; int c_sub;
    __device__ __forceinline__ void operator()(const Acc& acc, const Unit& u, int wr, int wc, int fr_, int fq_, LAS unsigned char*) const {
        int fr = fr_; asm volatile("" : "+v"(fr)); int fq = fq_; asm volatile("" : "+v"(fq));
        const int row0 = u.pm * BM + wr * 64 + fr, cw = wc * 32 + 8 * fq, c0 = (u.pn - c_sub) * 256;
#pragma unroll
        for (int ai = 0; ai < 2; ++ai)
#pragma unroll
            for (int m = 0; m < 4; ++m) { const int row = row0 + ai * HALF + m * 16;
#pragma unroll
                for (int bj = 0; bj < 2; ++bj) { f32x4 v0 = acc[ai][bj][m][0], v1 = acc[ai][bj][m][1];
                    v0.x = sigmoidf_fast(v0.x); v0.y = sigmoidf_fast(v0.y); v0.z = sigmoidf_fast(v0.z); v0.w = sigmoidf_fast(v0.w);
                    v1.x = sigmoidf_fast(v1.x); v1.y = sigmoidf_fast(v1.y); v1.z = sigmoidf_fast(v1.z); v1.w = sigmoidf_fast(v1.w);
                    u32x2 w8; w8.x = pk4_u8(v0.x, v0.y, v0.z, v0.w); w8.y = pk4_u8(v1.x, v1.y, v1.z, v1.w);
                    *(u32x2*)(O + (size_t)row * D + c0 + bj * HALF + cw) = w8; } }
    }
};
struct EpiUq {
    static constexpr bool PERM = true; static constexpr bool KEEP = false;
    unsigned char* QA; const float* ssq; const float* tab;
    __device__ __forceinline__ void operator()(const Acc& acc, const Unit& u, int wr, int wc, int fr, int fq, LAS unsigned char*) const {
        const int row0 = u.pm * BM + wr * 64 + fr;
#pragma unroll
        for (int ai = 0; ai < 2; ++ai) {
            f32x4 q0[4], q1[4], cs0[4], cs1[4];
#pragma unroll
            for (int m = 0; m < 4; ++m) { const int row = row0 + ai * HALF + m * 16, s = row & (S - 1);
                q0[m] = *(const f32x4*)(ssq + (size_t)row * 8); q1[m] = *(const f32x4*)(ssq + (size_t)row * 8 + 4);
                const f32x4* tp = (const f32x4*)(tab + (size_t)(s * 32 + 16 * (wc & 1) + 4 * fq) * 2); cs0[m] = tp[0]; cs1[m] = tp[1]; }
#pragma unroll
            for (int m = 0; m < 4; ++m) { const int row = row0 + ai * HALF + m * 16;
                const float rstd = rsqrtf((((q0[m].x + q0[m].y) + (q0[m].z + q0[m].w)) + ((q1[m].x + q1[m].y) + (q1[m].z + q1[m].w))) * (1.f / 512.f) + EPS) * (C2A * QS);
#pragma unroll
                for (int bj = 0; bj < 2; ++bj) { const int cg = u.pn * BM + bj * HALF + wc * 32; const bool rope = ((cg >> 6) % 3) == 2;
                    f32x4 v0 = acc[ai][bj][m][0] * rstd, v1 = acc[ai][bj][m][1] * rstd; if (rope) rope8(v0, v1, cs0[m], cs1[m]);
                    *(u32x2*)(QA + (size_t)row * 1536 + cg + 8 * fq) = pack8_fp8(v0, v1); } }
        }
    }
};
struct EpiUkv {
    static constexpr bool PERM = true; static constexpr bool KEEP = false;
    unsigned char* KA; const float* ssq; unsigned char* VT;
    __device__ __forceinline__ void operator()(const Acc& acc, const Unit& u, int wr, int wc, int fr, int fq, LAS unsigned char*) const {
        const int row0 = u.pm * BM + wr * 64 + fr, cw = wc * 32 + 8 * fq;
        f32x4 q0[2][4];
#pragma unroll
        for (int ai = 0; ai < 2; ++ai)
#pragma unroll
            for (int m = 0; m < 4; ++m) q0[ai][m] = *(const f32x4*)(ssq + (size_t)(row0 + ai * HALF + m * 16) * 4);
#pragma unroll
        for (int ai = 0; ai < 2; ++ai)
#pragma unroll
            for (int m = 0; m < 4; ++m) { const int row = row0 + ai * HALF + m * 16;
                const float rstd = rsqrtf(((q0[ai][m].x + q0[ai][m].y) + (q0[ai][m].z + q0[ai][m].w)) * (1.f / 256.f) + EPS);
                *(u32x2*)(KA + (size_t)row * 1024 + u.pn * HALF + cw) = pack8_fp8(acc[ai][0][m][0] * rstd, acc[ai][0][m][1] * rstd);
                const int b = row >> 11, sq = row & (S - 1);
                unsigned char* img = VT + ((size_t)((b * 8 + u.pn) * 32 + (sq >> 6)) * 128 + cw + (fr & 3)) * 64 + vpos(sq & 60);
#pragma unroll
                for (int n = 0; n < 2; ++n) { const f32x4 v = acc[ai][1][m][n] * rstd; *(unsigned*)(img + 4 * n * 64) = quad_tr4(pk4_fp8(v.x, v.y, v.z, v.w), fr & 3); } }
    }
};
__device__ __forceinline__ float gclamp(float g) { return fmaxf(g, 0.25f); }
__device__ __forceinline__ void ratio8(f32x4& v0, f32x4& v1, const u32x2 a, const u32x2 b) {
    v0.x *= ub0(a.x) * __builtin_amdgcn_rcpf(gclamp(ub0(b.x))); v0.y *= ub1(a.x) * __builtin_amdgcn_rcpf(gclamp(ub1(b.x)));
    v0.z *= ub2(a.x) * __builtin_amdgcn_rcpf(gclamp(ub2(b.x))); v0.w *= ub3(a.x) * __builtin_amdgcn_rcpf(gclamp(ub3(b.x)));
    v1.x *= ub0(a.y) * __builtin_amdgcn_rcpf(gclamp(ub0(b.y))); v1.y *= ub1(a.y) * __builtin_amdgcn_rcpf(gclamp(ub1(b.y)));
    v1.z *= ub2(a.y) * __builtin_amdgcn_rcpf(gclamp(ub2(b.y))); v1.w *= ub3(a.y) * __builtin_amdgcn_rcpf(gclamp(ub3(b.y))); }
__device__ __forceinline__ void gate8c(f32x4& v0, f32x4& v1, const u32x2 g) {
    constexpr float k = 1.f / 255.f;
    v0.x *= gclamp(ub0(g.x)) * k; v0.y *= gclamp(ub1(g.x)) * k; v0.z *= gclamp(ub2(g.x)) * k; v0.w *= gclamp(ub3(g.x)) * k;
    v1.x *= gclamp(ub0(g.y)) * k; v1.y *= gclamp(ub1(g.y)) * k; v1.z *= gclamp(ub2(g.y)) * k; v1.w *= gclamp(ub3(g.y)) * k; }
struct EpiBr {
    static constexpr bool PERM = true; static constexpr bool KEEP = true;
    unsigned char* MRG8; const unsigned char* GA; const unsigned char* GB;
    __device__ __forceinline__ void operator()(Acc& acc, const Unit& u, int wr, int wc, int fr, int fq, LAS unsigned char*) const {
        const int row0 = u.pm * BM + wr * 64 + fr, cw = wc * 32 + 8 * fq;
        const size_t off0 = (size_t)row0 * D + u.pn * BM + cw;
        if (u.aux == 0) {
            u32x2 g[2][4][2], h[2][4][2];
#pragma unroll
            for (int ai = 0; ai < 2; ++ai)
#pragma unroll
                for (int m = 0; m < 4; ++m)
#pragma unroll
                    for (int bj = 0; bj < 2; ++bj) { const size_t o = off0 + (size_t)(ai * HALF + m * 16) * D + bj * HALF; g[ai][m][bj] = *(const u32x2*)(GA + o); h[ai][m][bj] = *(const u32x2*)(GB + o); }
#pragma unroll
            for (int ai = 0; ai < 2; ++ai)
#pragma unroll
                for (int m = 0; m < 4; ++m)
#pragma unroll
                    for (int bj = 0; bj < 2; ++bj) ratio8(acc[ai][bj][m][0], acc[ai][bj][m][1], g[ai][m][bj], h[ai][m][bj]);
        } else {
            u32x2 g[2][4][2];
#pragma unroll
            for (int ai = 0; ai < 2; ++ai)
#pragma unroll
                for (int m = 0; m < 4; ++m)
#pragma unroll
                    for (int bj = 0; bj < 2; ++bj) g[ai][m][bj] = *(const u32x2*)(GB + off0 + (size_t)(ai * HALF + m * 16) * D + bj * HALF);
#pragma unroll
            for (int ai = 0; ai < 2; ++ai)
#pragma unroll
                for (int m = 0; m < 4; ++m)
#pragma unroll
                    for (int bj = 0; bj < 2; ++bj) { f32x4 v0 = acc[ai][bj][m][0], v1 = acc[ai][bj][m][1]; gate8c(v0, v1, g[ai][m][bj]);
                        u32x2 w8; w8.x = pk4_fp8(v0.x, v0.y, v0.z, v0.w); w8.y = pk4_fp8(v1.x, v1.y, v1.z, v1.w);
                        *(u32x2*)(MRG8 + off0 + (size_t)(ai * HALF + m * 16) * D + bj * HALF) = w8; }
        }
    }
};
struct EpiOut {
    static constexpr bool PERM = true; static constexpr bool KEEP = false;
    const float* x; bf16_t* X1; const float* mod; float* ssq;
    __device__ __forceinline__ void operator()(const Acc& acc, const Unit& u, int wr, int wc, int fr, int fq, LAS unsigned char*) const {
        const int row0 = u.pm * BM + wr * 64 + fr, col0 = u.pn * BM + wc * 32 + 8 * fq, b = (u.pm * BM) >> 11;
        const float* gt = mod + (size_t)b * 6 * D + 2 * D + col0;
        f32x4 gv[2][2];
#pragma unroll
        for (int bj = 0; bj < 2; ++bj)
#pragma unroll
            for (int n = 0; n < 2; ++n) gv[bj][n] = *(const f32x4*)(gt + bj * HALF + n * 4);
#pragma unroll
        for (int ai = 0; ai < 2; ++ai) {
            f32x4 xv[4][2][2];
#pragma unroll
            for (int m = 0; m < 4; ++m)
#pragma unroll
                for (int bj = 0; bj < 2; ++bj)
#pragma unroll
                    for (int n = 0; n < 2; ++n) xv[m][bj][n] = *(const f32x4*)(x + (size_t)(row0 + ai * HALF + m * 16) * D + col0 + bj * HALF + n * 4);
#pragma unroll
            for (int m = 0; m < 4; ++m) { const int row = row0 + ai * HALF + m * 16; const size_t off = (size_t)row * D + col0; float s = 0.f;
#pragma unroll
                for (int bj = 0; bj < 2; ++bj) { const f32x4 v0 = xv[m][bj][0] + gv[bj][0] * acc[ai][bj][m][0], v1 = xv[m][bj][1] + gv[bj][1] * acc[ai][bj][m][1];
                    s += dot8(v0, v1); ST16(X1 + off + bj * HALF, pack8(v0, v1)); }
                s += __shfl_xor(s, 16); s += __shfl_xor(s, 32);
                if (fq == 0) ssq[(size_t)row * 32 + u.pn * 4 + wc] = s; }
        }
    }
};
struct EpiGu {
    static constexpr bool PERM = true; static constexpr bool KEEP = false;
    bf16_t* ACT;
    __device__ __forceinline__ void operator()(const Acc& acc, const Unit& u, int wr, int wc, int fr, int fq, LAS unsigned char*) const {
        const int rl0 = wr * 64 + fr, cw = wc * 32 + 8 * fq;
#pragma unroll
        for (int ai = 0; ai < 2; ++ai)
#pragma unroll
            for (int m = 0; m < 4; ++m) { const int rl = rl0 + ai * HALF + m * 16;
                f32x4 r[2];
#pragma unroll
                for (int n = 0; n < 2; ++n) {
                    const f32x4 g = acc[ai][0][m][n], up = acc[ai][1][m][n];
                    r[n].x = g.x * sigmoidf_fast(g.x) * up.x; r[n].y = g.y * sigmoidf_fast(g.y) * up.y; r[n].z = g.z * sigmoidf_fast(g.z) * up.z; r[n].w = g.w * sigmoidf_fast(g.w) * up.w; }
                u32x2 w8; w8.x = pk4_fp8(r[0].x, r[0].y, r[0].z, r[0].w); w8.y = pk4_fp8(r[1].x, r[1].y, r[1].z, r[1].w);
                *(u32x2*)((unsigned char*)ACT + ((size_t)u.aux * CAP + rl) * FF + u.pn * HALF + cw) = w8; }
    }
};
struct EpiDn {
    static constexpr bool PERM = true; static constexpr bool KEEP = false;
    unsigned char* Y; const float* val;
    __device__ __forceinline__ void operator()(const Acc& acc, const Unit& u, int wr, int wc, int fr, int fq, LAS unsigned char*) const {
        const int rl0 = wr * 64 + fr, cw = wc * 32 + 8 * fq;
        float vv[2][4];
#pragma unroll
        for (int ai = 0; ai < 2; ++ai)
#pragma unroll
            for (int m = 0; m < 4; ++m) vv[ai][m] = val[u.aux * CAP + rl0 + ai * HALF + m * 16] * Y_SCALE;
#pragma unroll
        for (int ai = 0; ai < 2; ++ai)
#pragma unroll
            for (int m = 0; m < 4; ++m) { const int rl = rl0 + ai * HALF + m * 16; const float v = vv[ai][m];
#pragma unroll
                for (int bj = 0; bj < 2; ++bj) { const f32x4 v0 = acc[ai][bj][m][0] * v, v1 = acc[ai][bj][m][1] * v;
                    u32x2 w8; w8.x = pk4_fp8(v0.x, v0.y, v0.z, v0.w); w8.y = pk4_fp8(v1.x, v1.y, v1.z, v1.w);
                    *(u32x2*)(Y + ((size_t)u.aux * CAP + rl) * D + u.pn * BM + bj * HALF + cw) = w8; } }
    }
};
}

namespace at {
constexpr int NW = 8, QBLK = 32, KVBLK = 64, DV = 128;
constexpr float THR2 = 8.f;
#define SBAR() __builtin_amdgcn_sched_barrier(0)
__device__ __forceinline__ int crow(int r, int hi) { return (r & 3) + 8 * (r >> 2) + 4 * hi; }
__device__ __forceinline__ void partialSM(f32x16& p0, f32x16& p1, float& m_reg, float& alpha, f32x16& negm, const bool first) {
    float pmax = p0[0];
#pragma unroll
    for (int r = 1; r < 16; ++r) pmax = fmaxf(pmax, p0[r]);
#pragma unroll
    for (int r = 0; r < 16; ++r) pmax = fmaxf(pmax, p1[r]);
    { auto rr = __builtin_amdgcn_permlane32_swap(__float_as_uint(pmax), __float_as_uint(pmax), false, false);
      pmax = fmaxf(__uint_as_float(rr[0]), __uint_as_float(rr[1])); }
    if (__builtin_expect(!first && __all(pmax <= THR2), 1)) { alpha = 1.f; }
    else { const float d = first ? pmax : fmaxf(pmax, 0.f); alpha = first ? 1.f : __builtin_amdgcn_exp2f(-d); m_reg += d;
           { const float nd = -d; p0 = p0 + nd; p1 = p1 + nd; }
           const float nm = -m_reg;
#pragma unroll
           for (int r = 0; r < 16; ++r) negm[r] = nm; }
#pragma unroll
    for (int r = 0; r < 16; ++r) p0[r] = __builtin_amdgcn_exp2f(p0[r]);
}
typedef int v8i __attribute__((ext_vector_type(8)));
__device__ __forceinline__ void finishSM(f32x16& p0, f32x16& p1, float alpha, float& l_reg, v8i& pa) {
#pragma unroll
    for (int r = 0; r < 16; ++r) p1[r] = __builtin_amdgcn_exp2f(p1[r]);
    float ps;
    { typedef float f32x8v __attribute__((ext_vector_type(8))); typedef float f32x2v __attribute__((ext_vector_type(2)));
      const f32x16 t16 = p0 + p1; const f32x8v t8 = t16.lo + t16.hi; const f32x4 t4 = t8.lo + t8.hi; const f32x2v t2 = t4.lo + t4.hi; ps = t2.x + t2.y; }
    { auto rr = __builtin_amdgcn_permlane32_swap(__float_as_uint(ps), __float_as_uint(ps), false, false);
      ps = __uint_as_float(rr[0]) + __uint_as_float(rr[1]); }
    l_reg = l_reg * alpha + ps;
#pragma unroll
    for (int w = 0; w < 4; ++w) { pa[w] = (int)pk4_fp8(p0[4 * w], p0[4 * w + 1], p0[4 * w + 2], p0[4 * w + 3]); pa[4 + w] = (int)pk4_fp8(p1[4 * w], p1[4 * w + 1], p1[4 * w + 2], p1[4 * w + 3]); }
}
constexpr int VROW = 80;
__device__ __forceinline__ v8i vfrag(int vb, int d) { const pg::v4i lo = *(const LAS pg::v4i*)(size_t)(vb + d * 32 * VROW), hi4 = *(const LAS pg::v4i*)(size_t)(vb + d * 32 * VROW + 16); return __builtin_shufflevector(lo, hi4, 0, 1, 2, 3, 4, 5, 6, 7); }
__device__ __forceinline__ void pv_d0(f32x16* o, int vb, const v8i pa) {
    const int one = 0x7F7F7F7F;
    v8i vf[2]; vf[0] = vfrag(vb, 0);
    asm volatile("s_nop 4" ::: "memory");
#pragma unroll
    for (int d = 0; d < 4; ++d) {
        if (d + 1 < 4) vf[(d + 1) & 1] = vfrag(vb, d + 1);
        asm volatile("v_mfma_scale_f32_32x32x64_f8f6f4 %0, %1, %2, %0, %3, %4 op_sel_hi:[0,0,0]" : "+v"(o[d]) : "v"(pa), "v"(vf[d & 1]), "v"(one), "v"(one)); }
}
template <int DQK, int LDQ, int LDK1, int SDEPTH>
__device__ __forceinline__ void attn_unit(const unsigned char* __restrict__ Qb, const unsigned char* __restrict__ K1h, const unsigned char* __restrict__ K2, const unsigned char* __restrict__ Vimg  ,
                                          unsigned char* __restrict__ Ob, LAS unsigned char* lds) {
    constexpr int KROW = DQK + 16  , SHM_V = DV * VROW  , SHM_K = KVBLK * KROW, NKS = DQK / 64  ;
    constexpr bool HAS2 = (DQK == 192);
    const int wid = __builtin_amdgcn_readfirstlane(threadIdx.x >> 6);
    int lane = threadIdx.x & 63; asm volatile("" : "+v"(lane));
    const int tid = wid * 64 + lane, r32 = lane & 31, hi = lane >> 5;
    LAS unsigned char* V_lds = lds; LAS unsigned char* K_lds = lds + 3 * SHM_V;
    LAS float* wsf = (LAS float*)(lds + 3 * SHM_V + 3 * SHM_K) + wid * 64; LAS float* li_l = wsf; LAS float* al_l = wsf + 32;
    static_assert(3 * SHM_V + 3 * SHM_K + 2048 <= MISC_OFF && NW * 4096 <= MISC_OFF, "attention LDS image fits below the barrier words");
    float m_reg = 0.f, l_reg = 0; f32x16 o[4] = {}; f32x16 negm = {};
    v8i qf[NKS];
    { const unsigned char* Qw = Qb + (size_t)(wid * QBLK + r32) * LDQ + hi * 32;
#pragma unroll
      for (int ks = 0; ks < NKS; ++ks) { const pg::v4i lo = *(const pg::v4i*)(Qw + ks * 64), h4 = *(const pg::v4i*)(Qw + ks * 64 + 16); qf[ks] = __builtin_shufflevector(lo, h4, 0, 1, 2, 3, 4, 5, 6, 7); } }
    const int kr1 = tid >> 3, kc1 = (tid & 7) * 16;
    const int kr2 = (tid & 255) >> 2, kc2 = (tid & 3) * 16;
    const int vb0 = (int)(size_t)V_lds + r32 * VROW + hi * 32;
    const int kb0 = (int)(size_t)K_lds + r32 * KROW + hi * 32;
    constexpr int SE = 0;
    bf16x8 sV0[SDEPTH], sK0[SDEPTH], sK2[SDEPTH];
    const __amdgpu_buffer_rsrc_t rV = __builtin_amdgcn_make_buffer_rsrc((void*)Vimg, 0, 0x7fffffff, 0x00020000), rK1 = __builtin_amdgcn_make_buffer_rsrc((void*)K1h, 0, 0x7fffffff, 0x00020000);
    const __amdgpu_buffer_rsrc_t rK2 = __builtin_amdgcn_make_buffer_rsrc((void*)(HAS2 ? K2 : K1h), 0, 0x7fffffff, 0x00020000);
    const int voV = tid * 16, vwV = (tid >> 2) * VROW + (tid & 3) * 16, voK = kr1 * LDK1 + kc1, voK2 = kr2 * 64 + kc2;
#define BLD(r, vo, so) __builtin_bit_cast(bf16x8, __builtin_amdgcn_raw_buffer_load_b128(r, vo, so, 0))
#define SLOAD(i, k0) do { sV0[i] = BLD(rV, voV, (k0) * DV); sK0[i] = BLD(rK1, voK, (k0) * LDK1); \
    if constexpr (HAS2) sK2[i] = BLD(rK2, voK2, (k0) * 64); } while (0)
#define SWRITE(b, i) do { *(LAS bf16x8*)(V_lds + (b) * SHM_V + vwV) = sV0[i]; *(LAS bf16x8*)(K_lds + (b) * SHM_K + kr1 * KROW + kc1) = sK0[i]; \
    if constexpr (HAS2) { if (wid < 4) *(LAS bf16x8*)(K_lds + (b) * SHM_K + kr2 * KROW + 128 + kc2) = sK2[i]; } } while (0)
#define SWAIT() do { if constexpr (HAS2) asm volatile("s_waitcnt vmcnt(3)" ::: "memory"); else asm volatile("s_waitcnt vmcnt(2)" ::: "memory"); } while (0)
#define RESC(a) do { if (__any((a) < 1.f)) { if (hi == 0) al_l[r32] = (a); asm volatile("s_waitcnt lgkmcnt(0)" ::: "memory"); \
    _Pragma("unroll") for (int d = 0; d < 4; ++d) _Pragma("unroll") for (int r = 0; r < 16; ++r) o[d][r] *= al_l[crow(r, hi)]; } } while (0)
#define KFRAG(dst, blk, ks, KBOFF) do { const pg::v4i lo_ = *(const LAS pg::v4i*)(size_t)(kb0 + (KBOFF) + (blk) * 32 * KROW + (ks) * 64), h4_ = *(const LAS pg::v4i*)(size_t)(kb0 + (KBOFF) + (blk) * 32 * KROW + (ks) * 64 + 16); \
        dst = __builtin_shufflevector(lo_, h4_, 0, 1, 2, 3, 4, 5, 6, 7); } while (0)
#define QKT(P0, P1, KBOFF) do { const int one_ = 0x7F7F7F7F, qsc_ = 0x7B7B7B7B; v8i ka_[2][2];     \
    KFRAG(ka_[0][0], 0, 0, KBOFF); KFRAG(ka_[0][1], 1, 0, KBOFF); \
    _Pragma("unroll") for (int ks = 0; ks < NKS; ++ks) { \
        if (ks + 1 < NKS) { KFRAG(ka_[(ks + 1) & 1][0], 0, ks + 1, KBOFF); KFRAG(ka_[(ks + 1) & 1][1], 1, ks + 1, KBOFF); } \
        if (ks == 0) { \
            asm volatile("v_mfma_scale_f32_32x32x64_f8f6f4 %0, %1, %2, %3, %4, %5 op_sel_hi:[0,0,0]" : "=&v"(P0) : "v"(ka_[0][0]), "v"(qf[0]), "v"(negm), "v"(one_), "v"(qsc_)); \
            asm volatile("v_mfma_scale_f32_32x32x64_f8f6f4 %0, %1, %2, %3, %4, %5 op_sel_hi:[0,0,0]" : "=&v"(P1) : "v"(ka_[0][1]), "v"(qf[0]), "v"(negm), "v"(one_), "v"(qsc_)); \
        } else { \
            asm volatile("v_mfma_scale_f32_32x32x64_f8f6f4 %0, %1, %2, %0, %3, %4 op_sel_hi:[0,0,0]" : "+v"(P0) : "v"(ka_[ks & 1][0]), "v"(qf[ks]), "v"(one_), "v"(qsc_)); \
            asm volatile("v_mfma_scale_f32_32x32x64_f8f6f4 %0, %1, %2, %0, %3, %4 op_sel_hi:[0,0,0]" : "+v"(P1) : "v"(ka_[ks & 1][1]), "v"(qf[ks]), "v"(one_), "v"(qsc_)); } } \
    asm volatile("s_nop 15\n\ts_nop 7" ::: "memory"); } while (0)
    f32x16 pA0, pA1, pB0, pB1; float alA, alB; v8i pa; constexpr int NT = S / KVBLK;
    if (wid >= 4) __builtin_amdgcn_s_setprio(1);
    static_assert(SDEPTH == 2, "three LDS buffers fed through two register sets");
    int bc = 0, bn = 1, bw = 2;
#define STEP(t, SET, C0, C1, ALC, N0, N1, ALN) do { \
        SBAR(); QKT(N0, N1, bn * SHM_K); \
        finishSM(C0, C1, ALC, l_reg, pa); SBAR(); \
        SLOAD(1 - (SET), (((t) + 3 < NT) ? (t) + 3 : NT - 1) * KVBLK); SBAR();     \
        pv_d0(o, vb0 + bc * SHM_V, pa); partialSM(N0, N1, m_reg, ALN, negm, false);              \
        SWAIT(); if ((t) + 2 < NT) SWRITE(bw, SET); \
        RESC(ALN); __syncthreads(); \
        { const int tb = bc; bc = bn; bn = bw; bw = tb; } } while (0)
    SLOAD(0, 0); SLOAD(1, KVBLK); asm volatile("s_waitcnt vmcnt(0)" ::: "memory"); SWRITE(0, 0); SWRITE(1, 1); SLOAD(0, 2 * KVBLK); __syncthreads();
    QKT(pA0, pA1, 0); partialSM(pA0, pA1, m_reg, alA, negm, true);
    for (int t = 0; t + 2 < NT; t += 2) { STEP(t, 0, pA0, pA1, alA, pB0, pB1, alB); STEP(t + 1, 1, pB0, pB1, alB, pA0, pA1, alA); }
    STEP(NT - 2, 0, pA0, pA1, alA, pB0, pB1, alB);
    finishSM(pB0, pB1, alB, l_reg, pa); SBAR();
    pv_d0(o, vb0 + bc * SHM_V, pa);
    asm volatile("s_nop 15\n\ts_nop 15" ::: "memory");
#undef STEP
    __builtin_amdgcn_s_setprio(0);
    if (hi == 0) li_l[r32] = l_reg;
    asm volatile("s_waitcnt lgkmcnt(0)" ::: "memory");
    __syncthreads();
    float rli[16];
#pragma unroll
    for (int r = 0; r < 16; ++r) rli[r] = __builtin_amdgcn_rcpf(li_l[crow(r, hi)]);
    LAS unsigned char* stg = lds + wid * 4096;
#pragma unroll
    for (int r = 0; r < 16; ++r) { const int orow = crow(r, hi);
#pragma unroll
        for (int d0 = 0; d0 < 4; ++d0) { const float v = o[d0][r] * rli[r]; stg[orow * 128 + d0 * 32 + r32] = (unsigned char)(__builtin_amdgcn_cvt_pk_fp8_f32(v, v, 0, false) & 0xffu); } }
    asm volatile("s_waitcnt lgkmcnt(0)" ::: "memory");
    unsigned char* Ow = Ob + (size_t)(wid * QBLK) * 1024;
#pragma unroll
    for (int i = 0; i < 8; ++i) { const int row = i * 4 + (lane >> 4), ch = lane & 15; const u32x2 v = *(const LAS u32x2*)(stg + row * 128 + ch * 8); *(u32x2*)(Ow + (size_t)row * 1024 + ch * 8) = v; }
    asm volatile("s_waitcnt lgkmcnt(0)" ::: "memory");
    __syncthreads();
#undef SLOAD
#undef BLD
#undef SWRITE
#undef SWAIT
#undef RESC
#undef QKT
#undef KFRAG
}
#undef SBAR
}

struct MArgs { const float* in[21]; float* out; unsigned char* ws; int ph_lo, ph_hi, li, pad; };

template <bool OUT8 = false, class RowMap>
__device__ __forceinline__ void conv_item(const float* __restrict__ W, int ldw, int K, int k0, int n0, bf16_t* __restrict__ WT, const float* __restrict__ kscale, LAS float* scr, int lane, const RowMap& rowmap) {
#pragma unroll 8
    for (int i = 0; i < 32; ++i) { const int kk = 2 * i + (lane >> 5); float v = W[(size_t)(k0 + kk) * ldw + n0 + (lane & 31)]; if (kscale) v *= kscale[k0 + kk]; scr[kk * 33 + (lane & 31)] = v; }
    asm volatile("s_waitcnt lgkmcnt(0)" ::: "memory");
    const int c = lane & 7;
#pragma unroll
    for (int j = 0; j < 4; ++j) { const int n = (lane >> 3) + 8 * j; const LAS float* s = scr + (8 * c) * 33 + n;
        if constexpr (OUT8) { u32x2 o; o.x = pk4_fp8(s[0 * 33] * W8_SCALE, s[1 * 33] * W8_SCALE, s[2 * 33] * W8_SCALE, s[3 * 33] * W8_SCALE); o.y = pk4_fp8(s[4 * 33] * W8_SCALE, s[5 * 33] * W8_SCALE, s[6 * 33] * W8_SCALE, s[7 * 33] * W8_SCALE);
            *(u32x2*)((unsigned char*)WT + (size_t)rowmap(n0 + n) * K + k0 + 8 * c) = o; }
        else { u32x4 o; o.x = pk2(s[0 * 33], s[1 * 33]); o.y = pk2(s[2 * 33], s[3 * 33]); o.z = pk2(s[4 * 33], s[5 * 33]); o.w = pk2(s[6 * 33], s[7 * 33]);
            *(u32x4*)(WT + (size_t)rowmap(n0 + n) * K + k0 + 8 * c) = o; } }
    asm volatile("s_waitcnt lgkmcnt(0)" ::: "memory");
}
__device__ __forceinline__ int il64(int j) { return (j < 32) ? 2 * j : 2 * (j - 32) + 1; }
__device__ __forceinline__ int il128(int d) { return (d & 64) + il64(d & 63); }
struct MapIn { __device__ __forceinline__ int operator()(int n) const {
    if (n < C_KR) return n; if (n < C_QG) return 768 + il64(n - C_KR);
    if (n < C_KG) { const int m = n - C_QG; return 1024 + (m & ~127) + il128(m & 127); }
    if (n < C_VG) { const int m = n - C_KG; return 2048 + (m & ~127) + il128(m & 127); }
    if (n < C_GA) return 2304 + (n - C_VG); if (n < C_GB) return 2560 + (n - C_GA); return 4608 + (n - C_GB); } };
struct MapUq { __device__ __forceinline__ int operator()(int n) const { const int h = n / 192, j = n - h * 192; return j < 128 ? n : h * 192 + 128 + il64(j - 128); } };
struct MapId { int off; __device__ __forceinline__ int operator()(int n) const { return off + n; } };
struct MapGu { int base; __device__ __forceinline__ int operator()(int f) const { return base + (f >> 7) * 256 + (f & 127); } };

__device__ __forceinline__ void phase_modp(const MArgs& a, LAS unsigned char* lds, int vcu, int G, int tid, int lane, int wave) {
    unsigned char* ws = a.ws;
    { const int gt = vcu * NTHR + tid, nitem = MOD_SPLIT * (6 * D / 4);
      const float* c = a.in[1]; const float* w_ada = a.in[2]; float* modp = (float*)(ws + WS_MODP);
      for (int it = gt; it < nitem; it += G * NTHR) {
          const int sp = it / (6 * D / 4), cg = it - sp * (6 * D / 4), k0 = sp * (D / MOD_SPLIT);
          f32x4 acc[NB];
#pragma unroll
          for (int b = 0; b < NB; ++b) acc[b] = (f32x4){0.f, 0.f, 0.f, 0.f};
#pragma unroll 4
          for (int k = 0; k < D / MOD_SPLIT; ++k) {
              const f32x4 w = *(const f32x4*)(w_ada + (size_t)(k0 + k) * (6 * D) + 4 * cg);
#pragma unroll
              for (int b = 0; b < NB; ++b) { const float cv = c[b * D + k0 + k]; const float sv = cv * sigmoidf_fast(cv); acc[b] += w * sv; }
          }
#pragma unroll
          for (int b = 0; b < NB; ++b) *(f32x4*)(modp + ((size_t)sp * NB + b) * (6 * D) + 4 * cg) = acc[b];
      } }
    { float* tab = (float*)(ws + WS_TAB); float* gp = (float*)(ws + WS_GP);
      for (int t = vcu * NTHR + tid; t < 2048 * 32; t += G * NTHR) {
          const int pos = t >> 5, i = t & 31;
          double f = 1.0; for (int j = 0; j < i; ++j) f *= 0.74989420933245582730;
          const float ff = (float)f; const float ang = (float)pos * ff;
          double s, c; sincos_d((double)ang, s, c);
          tab[2 * t] = (float)c; tab[2 * t + 1] = (float)s;
      }
      if (vcu == 0 && tid < 128) { gp[tid] = a.in[10][perm_old_dim(tid)]; gp[128 + tid] = a.in[11][perm_old_dim(tid)]; } }
    { LAS float* scr = (LAS float*)(lds + wave * 8448);
      const int gw = vcu * NWAVES + wave, NGW = G * NWAVES;
      constexpr int I_IN = (D / 64) * (IN_COLS / 32), I_UQ = (512 / 64) * (1536 / 32), I_UKV = (256 / 64) * (2048 / 32), I_BR = (1024 / 64) * (2048 / 32), I_OUT = (2048 / 64) * (2048 / 32);
      constexpr int NITEMS = I_IN + I_UQ + I_UKV + 2 * I_BR + I_OUT;
      for (int it = gw; it < NITEMS; it += NGW) {
          int r = it;
          if (r < I_IN) { const int nb = IN_COLS / 32; conv_item<true>(a.in[5], IN_COLS, D, 64 * (r / nb), 32 * (r % nb), (bf16_t*)(ws + WS_WIN), nullptr, scr, lane, MapIn{}); continue; } r -= I_IN;
          if (r < I_UQ) { const int nb = 1536 / 32; conv_item<true>(a.in[8], 1536, 512, 64 * (r / nb), 32 * (r % nb), (bf16_t*)(ws + WS_WUQ), a.in[6], scr, lane, MapUq{}); continue; } r -= I_UQ;
          if (r < I_UKV) { const int nb = 2048 / 32; conv_item<true>(a.in[9], 2048, 256, 64 * (r / nb), 32 * (r % nb), (bf16_t*)(ws + WS_WUKV), a.in[7], scr, lane, MapId{0}); continue; } r -= I_UKV;
          if (r < I_BR) { const int nb = 2048 / 32; conv_item<true>(a.in[12], 2048, 1024, 64 * (r / nb), 32 * (r % nb), (bf16_t*)(ws + WS_WBRA), nullptr, scr, lane, MapId{0}); continue; } r -= I_BR;
          if (r < I_BR) { const int nb = 2048 / 32; conv_item<true>(a.in[13], 2048, 1024, 64 * (r / nb), 32 * (r % nb), (bf16_t*)(ws + WS_WBRB), nullptr, scr, lane, MapId{0}); continue; } r -= I_BR;
          { const int nb = 2048 / 32; conv_item<true>(a.in[14], 2048, 2048, 64 * (r / nb), 32 * (r % nb), (bf16_t*)(ws + WS_WOUT), nullptr, scr, lane, MapId{0}); }
      }
      u32x4* z = (u32x4*)(ws + WS_WIN + (size_t)832 * D);
      for (int t = vcu * NTHR + tid; t < 192 * D / 16; t += G * NTHR) z[t] = (u32x4){0u, 0u, 0u, 0u};
    }
}
struct ConvIt { const float* W; int k0, n0, rowbase; };
template <int NB_, bool GU>
__device__ __forceinline__ void conv_items(const ConvIt (&it)[NB_], int ldw, int K, unsigned char* __restrict__ WT, LAS float* scr, int lane) {
    const int kr = lane >> 3, nq = lane & 7, c = lane & 7;
    f32x4 v[NB_][8];
#pragma unroll
    for (int b = 0; b < NB_; ++b)
#pragma unroll
        for (int i = 0; i < 8; ++i) v[b][i] = *(const f32x4*)(it[b].W + (size_t)(it[b].k0 + 8 * i + kr) * ldw + it[b].n0 + 4 * nq);
#pragma unroll
    for (int b = 0; b < NB_; ++b) {
#pragma unroll
        for (int i = 0; i < 8; ++i) *(LAS f32x4*)(scr + (8 * i + kr) * 32 + 4 * (nq ^ i)) = v[b][i];
        asm volatile("s_waitcnt lgkmcnt(0)" ::: "memory");
        { const int q4 = lane >> 3; f32x4 r[8];
#pragma unroll
          for (int i = 0; i < 8; ++i) r[i] = *(const LAS f32x4*)(scr + (8 * c + i) * 32 + 4 * (q4 ^ c)) * W8_SCALE;
#pragma unroll
          for (int e = 0; e < 4; ++e) { const int nn = it[b].n0 + 4 * q4 + e;
            const int drow = GU ? it[b].rowbase + (nn >> 7) * 256 + (nn & 127) : it[b].rowbase + nn;
            u32x2 o; o.x = pk4_fp8(r[0][e], r[1][e], r[2][e], r[3][e]); o.y = pk4_fp8(r[4][e], r[5][e], r[6][e], r[7][e]);
            *(u32x2*)(WT + (size_t)drow * K + it[b].k0 + 8 * c) = o; } }
        asm volatile("s_waitcnt lgkmcnt(0)" ::: "memory");
    }
}
__device__ __forceinline__ void phase_expert_conv(const MArgs& a, LAS unsigned char* lds, int gw, int NGW, int lane, int wave, int slot, int nslots) {
    unsigned char* ws = a.ws; LAS float* scr = (LAS float*)(lds + wave * 8448);
    constexpr int I_G1 = (D / 64) * (FF / 32), I_GU = NE * I_G1, I_D1 = (FF / 64) * (D / 32), I_DN = NE * I_D1, NBAT = 2;
    const int step = nslots * NGW;
    for (int fam = 0; fam < 3; ++fam) {
        const int NI = fam < 2 ? I_GU : I_DN;
        for (int it0 = gw + slot * NGW; it0 < NI; it0 += NBAT * step) {
            ConvIt ci[NBAT];
#pragma unroll
            for (int b = 0; b < NBAT; ++b) { const int it = (it0 + b * step < NI) ? it0 + b * step : it0;
                if (fam < 2) { const int e = it / I_G1, q = it % I_G1, nb = FF / 32; ci[b] = ConvIt{a.in[17 + fam] + (size_t)e * D * FF, 64 * (q / nb), 32 * (q % nb), e * 2048 + fam * 128}; }
                else { const int e = it / I_D1, q = it % I_D1, nb = D / 32; ci[b] = ConvIt{a.in[19] + (size_t)e * FF * D, 64 * (q / nb), 32 * (q % nb), e * 2048}; } }
            if (fam < 2) conv_items<NBAT, true>(ci, FF, D, ws + WS_WGU, scr, lane);
            else conv_items<NBAT, false>(ci, D, FF, ws + WS_WDN, scr, lane);
        }
    }
    __syncthreads();
}
__device__ __forceinline__ void modr_all(const MArgs& a, int vcu, int G, int tid) {
    const float* modp = (const float*)(a.ws + WS_MODP); float* mod = (float*)(a.ws + WS_MOD); const float* b_ada = a.in[3];
    constexpr int N = NB * 6 * D / 4; const int per = (N + G - 1) / G;
    for (int i = tid; i < per; i += NTHR) {
        const int t = vcu * per + i; if (t >= N) break;
        const int b = t / (6 * D / 4), cg = t - b * (6 * D / 4);
        f32x4 s = *(const f32x4*)(b_ada + 4 * cg);
        for (int sp = 0; sp < MOD_SPLIT; ++sp) s += *(const f32x4*)(modp + ((size_t)sp * NB + b) * (6 * D) + 4 * cg);
        *(f32x4*)(mod + (size_t)b * 6 * D + 4 * cg) = s;
    }
}
__device__ __forceinline__ void phase_xn(const MArgs& a, LAS unsigned char* lds, int vcu, int G, int tid, int lane, int wave) {
    const float* x = a.in[0]; const float* g = a.in[4]; const float* modp = (const float*)(a.ws + WS_MODP); const float* b_ada = a.in[3]; unsigned char* xn = a.ws + WS_XN;
    LAS f32x4* GM = (LAS f32x4*)lds; LAS f32x4* SH = GM + D / 4;
    for (int blk = vcu; blk < M / 64; blk += G) {
        const int b = blk >> 5;
        for (int i = tid; i < D / 2; i += NTHR) {
            f32x4 s = *(const f32x4*)(b_ada + 4 * i);
            for (int sp = 0; sp < MOD_SPLIT; ++sp) s += *(const f32x4*)(modp + ((size_t)sp * NB + b) * (6 * D) + 4 * i);
            if (i < D / 4) SH[i] = s; else GM[i - D / 4] = ((const f32x4*)g)[i - D / 4] * (1.f + s);
        }
        __syncthreads();
        for (int r = wave; r < 64; r += NWAVES) {
            const int row = blk * 64 + r;
            const f32x4* xr = (const f32x4*)(x + (size_t)row * D) + lane;
            f32x4 v[8]; float s = 0.f;
#pragma unroll
            for (int j = 0; j < 8; ++j) { v[j] = xr[64 * j]; s += v[j].x * v[j].x + v[j].y * v[j].y + v[j].z * v[j].z + v[j].w * v[j].w; }
            const float rstd = rsqrtf(wave_sum(s) * (1.f / D) + EPS);
            unsigned* o = (unsigned*)(xn + (size_t)row * D) + lane;
#pragma unroll
            for (int j = 0; j < 8; ++j) { const f32x4 y = v[j] * rstd * GM[64 * j + lane] + SH[64 * j + lane]; o[64 * j] = pk4_fp8(y.x, y.y, y.z, y.w); }
        }
        __syncthreads();
    }
    modr_all(a, vcu, G, tid);
}
__device__ __forceinline__ void split8(const f32x4 y0, const f32x4 y1, bf16x8& hi, bf16x8& lo) {
    const u32x4 h = pack8(y0, y1);
    const f32x4 r0 = y0 - (f32x4){bflo(h.x), bfhi(h.x), bflo(h.y), bfhi(h.y)}, r1 = y1 - (f32x4){bflo(h.z), bfhi(h.z), bflo(h.w), bfhi(h.w)};
    hi = __builtin_bit_cast(bf16x8, h); lo = __builtin_bit_cast(bf16x8, pack8(r0, r1)); }
__device__ __forceinline__ void phase_router(const MArgs& a, LAS unsigned char* lds, int vcu, int G, int lane, int tid, int wave) {
    const bf16_t* x1 = (const bf16_t*)(a.ws + WS_X1); const float* ssq = (const float*)(a.ws + WS_SSQX1); const float* g = a.in[15]; const float* mod = (const float*)(a.ws + WS_MOD); const float* wr = a.in[16];
    unsigned char* h2 = a.ws + WS_H2; float* aff = (float*)(a.ws + WS_AFF); int* rank = (int*)(a.ws + WS_RANK);
    LAS float* GM = (LAS float*)lds; LAS float* SH = GM + D;
    LAS f32x4* PART = (LAS f32x4*)(lds + 2 * D * 4);
    const int fr = lane & 15, fq = lane >> 4, k0 = wave * 256 + 8 * fq;
    bf16x8 whi[8], wlo[8];
#pragma unroll
    for (int s = 0; s < 8; ++s) { f32x4 w0, w1;
#pragma unroll
        for (int i = 0; i < 4; ++i) { w0[i] = wr[(size_t)(k0 + 32 * s + i) * NE + fr]; w1[i] = wr[(size_t)(k0 + 32 * s + 4 + i) * NE + fr]; }
        split8(w0, w1, whi[s], wlo[s]); }
    for (int blk = vcu; blk < M / 64; blk += G) {
        const int b = blk >> 5;
        const float* sh = mod + (size_t)b * 6 * D + 3 * D; const float* sc = sh + D;
        for (int i = tid; i < D / 4; i += NTHR) { const f32x4 gg = ((const f32x4*)g)[i], cc = ((const f32x4*)sc)[i]; ((LAS f32x4*)GM)[i] = gg * (1.f + cc); ((LAS f32x4*)SH)[i] = ((const f32x4*)sh)[i]; }
        __syncthreads();
#pragma unroll 1
        for (int tp = 0; tp < 4; tp += 2) {
            int rowt[2]; f32x4 q0[2], q1[2]; u32x4 xw[2][8];
#pragma unroll
            for (int u = 0; u < 2; ++u) { rowt[u] = blk * 64 + 16 * (tp + u) + fr;
                q0[u] = *(const f32x4*)(ssq + (size_t)rowt[u] * 32 + 8 * fq); q1[u] = *(const f32x4*)(ssq + (size_t)rowt[u] * 32 + 8 * fq + 4);
#pragma unroll
                for (int s = 0; s < 8; ++s) xw[u][s] = *(const u32x4*)(x1 + (size_t)rowt[u] * D + k0 + 32 * s); }
#pragma unroll
            for (int u = 0; u < 2; ++u) {
                asm volatile("" ::: "memory");
                const int row = rowt[u];
                float sq = ((q0[u].x + q0[u].y) + (q0[u].z + q0[u].w)) + ((q1[u].x + q1[u].y) + (q1[u].z + q1[u].w));
                sq += __shfl_xor(sq, 16); sq += __shfl_xor(sq, 32);
                const float rstd = rsqrtf(sq * (1.f / D) + EPS);
                f32x4 acc = (f32x4){0.f, 0.f, 0.f, 0.f};
#pragma unroll
                for (int s = 0; s < 8; ++s) {
                    const int k = k0 + 32 * s;
                    const f32x4 g0 = *(const LAS f32x4*)(GM + k), g1 = *(const LAS f32x4*)(GM + k + 4), s0 = *(const LAS f32x4*)(SH + k), s1 = *(const LAS f32x4*)(SH + k + 4);
                    const f32x4 y0 = (f32x4){bflo(xw[u][s].x), bfhi(xw[u][s].x), bflo(xw[u][s].y), bfhi(xw[u][s].y)} * rstd * g0 + s0;
                    const f32x4 y1 = (f32x4){bflo(xw[u][s].z), bfhi(xw[u][s].z), bflo(xw[u][s].w), bfhi(xw[u][s].w)} * rstd * g1 + s1;
                    u32x2 w8; w8.x = pk4_fp8(y0.x, y0.y, y0.z, y0.w); w8.y = pk4_fp8(y1.x, y1.y, y1.z, y1.w);
                    *(u32x2*)(h2 + (size_t)row * D + k) = w8;
                    bf16x8 hi, lo; split8(y0, y1, hi, lo);
                    acc = __builtin_amdgcn_mfma_f32_16x16x32_bf16(whi[s], hi, acc, 0, 0, 0);
                    acc = __builtin_amdgcn_mfma_f32_16x16x32_bf16(wlo[s], hi, acc, 0, 0, 0);
                    acc = __builtin_amdgcn_mfma_f32_16x16x32_bf16(whi[s], lo, acc, 0, 0, 0);
                }
                PART[((tp + u) * 8 + wave) * 64 + lane] = acc;
            }
        }
        __syncthreads();
        if (wave < 4) {
            const int row = blk * 64 + 16 * wave + fr, sidx = row & (S - 1);
            f32x4 lg = PART[(wave * 8) * 64 + lane];
#pragma unroll
            for (int w = 1; w < 8; ++w) lg += PART[(wave * 8 + w) * 64 + lane];
            float mx = fmaxf(fmaxf(lg.x, lg.y), fmaxf(lg.z, lg.w));
            mx = fmaxf(mx, __shfl_xor(mx, 16)); mx = fmaxf(mx, __shfl_xor(mx, 32));
            f32x4 ev = (f32x4){expf(lg.x - mx), expf(lg.y - mx), expf(lg.z - mx), expf(lg.w - mx)};
            float den = (ev.x + ev.y) + (ev.z + ev.w);
            den += __shfl_xor(den, 16); den += __shfl_xor(den, 32);
#pragma unroll
            for (int i = 0; i < 4; ++i) aff[((size_t)b * NE + 4 * fq + i) * S + sidx] = ev[i] / den;
            *(int4*)(rank + (size_t)row * NE + 4 * fq) = make_int4(-1, -1, -1, -1);
        }
        __syncthreads();
    }
}
__device__ __forceinline__ void phase_topk(const MArgs& a, LAS unsigned char* lds, int pair, int tid, int lane, int wave) {
    const float* aff = (const float*)(a.ws + WS_AFF); int* idx = (int*)(a.ws + WS_IDX); float* val = (float*)(a.ws + WS_VAL); int* rank = (int*)(a.ws + WS_RANK);
    LAS unsigned* CNT = (LAS unsigned*)lds; LAS unsigned* TOT = CNT + 256;
    const int b = pair >> 4, e = pair & 15;
    const u32x4 kk = *(const u32x4*)(aff + (size_t)pair * S + 4 * tid);
    unsigned lo = 0u, hi = 0x3F800001u;
    for (int it = 0; hi - lo > 1u; ++it) {
        const unsigned step = (hi - lo + 15u) >> 4;
        unsigned mine = 0u;
#pragma unroll
        for (int i = 1; i < 16; ++i) {
            const unsigned p = min(lo + (unsigned)i * step, hi);
            const unsigned c = (unsigned)(__popcll(__ballot(kk.x >= p)) + __popcll(__ballot(kk.y >= p)) + __popcll(__ballot(kk.z >= p)) + __popcll(__ballot(kk.w >= p)));
            mine = (lane == i) ? c : mine;
        }
        LAS unsigned* buf = CNT + (it & 1) * 128;
        if (lane < 16) buf[wave * 16 + lane] = mine;
        __syncthreads();
        unsigned tot = 0u;
        if (lane < 16) {
#pragma unroll
            for (int w = 0; w < NWAVES; ++w) tot += buf[w * 16 + lane]; }
        const int i = __popcll(__ballot(lane >= 1 && lane < 16 && tot >= (unsigned)CAP));
        const unsigned nlo = lo + (unsigned)i * step, nhi = (i < 15) ? min(lo + (unsigned)(i + 1) * step, hi) : hi;
        lo = (unsigned)__builtin_amdgcn_readfirstlane((int)nlo); hi = (unsigned)__builtin_amdgcn_readfirstlane((int)nhi);
    }
    const unsigned T = lo;
    const unsigned pk = (unsigned)((kk.x > T) + (kk.y > T) + (kk.z > T) + (kk.w > T)) | ((unsigned)((kk.x == T) + (kk.y == T) + (kk.z == T) + (kk.w == T)) << 16);
    unsigned inc = pk;
#pragma unroll
    for (int d = 1; d < 64; d <<= 1) { const unsigned t = __shfl_up(inc, d); if (lane >= d) inc += t; }
    if (lane == 63) TOT[wave] = inc;
    __syncthreads();
    unsigned base = 0u, all = 0u;
#pragma unroll
    for (int w = 0; w < NWAVES; ++w) { const unsigned t = TOT[w]; all += t; base += (w < wave) ? t : 0u; }
    const unsigned total_g = all & 0xffffu, need_eq = (unsigned)CAP - total_g, excl = base + inc - pk;
    unsigned gpos = excl & 0xffffu, qpos = excl >> 16;
#pragma unroll
    for (int j = 0; j < 4; ++j) {
        const unsigned k = kk[j]; const int t = 4 * tid + j; int slot = -1;
        if (k > T) slot = (int)gpos++; else if (k == T) { if (qpos < need_eq) slot = (int)(total_g + qpos); ++qpos; }
        if (slot >= 0) { idx[pair * CAP + slot] = t; val[pair * CAP + slot] = __builtin_bit_cast(float, k); rank[((size_t)b * S + t) * NE + e] = slot; }
    }
    __syncthreads();
}
__device__ __forceinline__ float dot8s(f32x4 a, f32x4 b) { return (a.x * a.x + a.y * a.y + a.z * a.z + a.w * a.w) + (b.x * b.x + b.y * b.y + b.z * b.z + b.w * b.w); }
__device__ __forceinline__ void acc8_fp8(f32x4& a0, f32x4& a1, const u32x2 w) {
    typedef float f32x2v __attribute__((ext_vector_type(2)));
    const f32x2v p0 = __builtin_amdgcn_cvt_pk_f32_fp8((int)w.x, false), p1 = __builtin_amdgcn_cvt_pk_f32_fp8((int)w.x, true);
    const f32x2v p2 = __builtin_amdgcn_cvt_pk_f32_fp8((int)w.y, false), p3 = __builtin_amdgcn_cvt_pk_f32_fp8((int)w.y, true);
    a0.x += p0.x; a0.y += p0.y; a0.z += p1.x; a0.w += p1.y; a1.x += p2.x; a1.y += p2.y; a1.z += p3.x; a1.w += p3.y; }
__device__ __forceinline__ void phase_final(const MArgs& a, int gw, int NGW, int lane) {
    float* out = a.out; const unsigned char* Y = a.ws + WS_Y; const int* rank = (const int*)(a.ws + WS_RANK); const float* mod = (const float*)(a.ws + WS_MOD); const float* gf = a.in[20];
    for (int row = gw; row < M; row += NGW) {
        const int b = row >> 11;
        const float* gt = mod + (size_t)b * 6 * D + 5 * D;
        f32x4* xp = (f32x4*)(out + (size_t)row * D) + 2 * lane; const u32x4* x1p = (const u32x4*)((const bf16_t*)(a.ws + WS_X1) + (size_t)row * D) + lane;
        const int rk = (lane < NE) ? rank[(size_t)row * NE + lane] : -1;
        u32x4 xw[4];
#pragma unroll
        for (int j = 0; j < 4; ++j) xw[j] = x1p[64 * j];
        unsigned long long mask = __ballot(rk >= 0) & 0xffffull;
        f32x4 acc[4][2];
#pragma unroll
        for (int j = 0; j < 4; ++j) { acc[j][0] = (f32x4){0.f, 0.f, 0.f, 0.f}; acc[j][1] = (f32x4){0.f, 0.f, 0.f, 0.f}; }
        while (mask) {
            const int e0 = __builtin_ctzll(mask); mask &= mask - 1;
            const int e1 = mask ? __builtin_ctzll(mask) : -1; if (e1 >= 0) mask &= mask - 1;
            const int r0 = __builtin_amdgcn_readlane(rk, e0), r1 = (e1 >= 0) ? __builtin_amdgcn_readlane(rk, e1 >= 0 ? e1 : 0) : 0;
            const u32x2* y0 = (const u32x2*)(Y + ((size_t)(b * NE + e0) * CAP + r0) * D) + lane;
            const u32x2* y1 = (const u32x2*)(Y + ((size_t)(b * NE + (e1 >= 0 ? e1 : e0)) * CAP + (e1 >= 0 ? r1 : r0)) * D) + lane;
            u32x2 w0[4], w1[4];
#pragma unroll
            for (int j = 0; j < 4; ++j) w0[j] = y0[64 * j];
#pragma unroll
            for (int j = 0; j < 4; ++j) w1[j] = y1[64 * j];
#pragma unroll
            for (int j = 0; j < 4; ++j) acc8_fp8(acc[j][0], acc[j][1], w0[j]);
            if (e1 >= 0) {
#pragma unroll
                for (int j = 0; j < 4; ++j) acc8_fp8(acc[j][0], acc[j][1], w1[j]);
            }
        }
        float s = 0.f;
#pragma unroll
        for (int j = 0; j < 4; ++j) { const int d = 8 * (64 * j + lane);
            const f32x4 x0 = (f32x4){bflo(xw[j].x), bfhi(xw[j].x), bflo(xw[j].y), bfhi(xw[j].y)}, x1 = (f32x4){bflo(xw[j].z), bfhi(xw[j].z), bflo(xw[j].w), bfhi(xw[j].w)};
            acc[j][0] = x0 + *(const f32x4*)(gt + d) * (1.f / Y_SCALE) * acc[j][0]; acc[j][1] = x1 + *(const f32x4*)(gt + d + 4) * (1.f / Y_SCALE) * acc[j][1];
            s += dot8s(acc[j][0], acc[j][1]); }
        const float rstd = rsqrtf(wave_sum(s) * (1.f / D) + EPS);
#pragma unroll
        for (int j = 0; j < 4; ++j) { const int d = 8 * (64 * j + lane); xp[128 * j] = acc[j][0] * rstd * *(const f32x4*)(gf + d); xp[128 * j + 1] = acc[j][1] * rstd * *(const f32x4*)(gf + d + 4); }
    }
}

__device__ __forceinline__ int opaque_lane() { int t = threadIdx.x; asm volatile("" : "+v"(t)); return t & 63; }
enum { PH_MODP = 0, PH_XN, PH_GEMM1, PH_UP, PH_ATTN, PH_BR, PH_OUT, PH_ROUTER, PH_TOPK, PH_GATEUP, PH_DOWN, PH_FINAL, PH_N };
__global__ void __launch_bounds__(NTHR, 2) mega(MArgs args) {
    extern __shared__ __attribute__((aligned(16))) unsigned char lds_raw[];
    LAS unsigned char* lds = (LAS unsigned char*)lds_raw;
    volatile LAS unsigned* MISC = (volatile LAS unsigned*)(lds + MISC_OFF);
    const int tid = threadIdx.x, wave = __builtin_amdgcn_readfirstlane(tid >> 6);
#define lane opaque_lane()
    const int G = gridDim.x, bx = blockIdx.x, vcu = (G % 8 == 0) ? (bx % 8) * (G / 8) + bx / 8 : bx;
    const int gw = vcu * NWAVES + wave, NGW = G * NWAVES;
    unsigned char* ws = args.ws;
    for (int u = tid; u < (LDS_BYTES - MISC_OFF) / 4; u += NTHR) MISC[u] = 0u;
    __syncthreads();
    XcdBarrier bar = xcd_barrier_post((unsigned*)(ws + WS_CTL) + CW_BAR + args.li * XCD_BAR_WORDS, MISC + 8);
    const int lo = args.ph_lo, hi = args.ph_hi;
#define IN(k) (lo <= (k) && (k) < hi)
#define SEAM(k) do { if (IN(k) && IN((k) + 1)) xcd_barrier(bar); } while (0)

    if (IN(PH_MODP)) { phase_modp(args, lds, vcu, G, tid, lane, wave); } SEAM(PH_MODP);
    if (IN(PH_XN)) { phase_xn(args, lds, vcu, G, tid, lane, wave); } SEAM(PH_XN);
    if (IN(PH_GEMM1)) {
        pg::GridSched Sd; Sd.init(ws + WS_XN, ws + WS_WIN, D / 2, D / 2, M, IN_PAD, G, bx);
        pg::EpiIn E{(bf16_t*)(ws + WS_CQ), (bf16_t*)(ws + WS_CKV), ws + WS_KR, ws + WS_QG, ws + WS_KG, ws + WS_VTG, ws + WS_GA, ws + WS_GB,
                    (float*)(ws + WS_SSQCQ), (float*)(ws + WS_SSQKV), (const float*)(ws + WS_TAB), (const float*)(ws + WS_GP)};
        if (G == 256) Sd.r1 = 6;
        pg::gemm_phase<pg::EpiIn, pg::GridSched, false, true>(lds, ws, D / 2, D / 2, Sd, E, nullptr);
    } SEAM(PH_GEMM1);
    if (IN(PH_UP)) {
        const bool deal = (G == 256); const int c2 = bx - 128;
        if (deal && bx < 128) {
            pg::GridSched Sd; Sd.init(ws + WS_XN, ws + WS_WIN, D / 2, D / 2, M, IN_PAD, G, bx); Sd.r0 = 6;
            pg::EpiGate E{ws + WS_GB, 18};
            pg::gemm_phase<pg::EpiGate, pg::GridSched, false, true>(lds, ws, D / 2, D / 2, Sd, E, nullptr);
        }
        { pg::EpiUq E{ws + WS_QA, (const float*)(ws + WS_SSQCQ), (const float*)(ws + WS_TAB)};
          pg::ListSched Sd{(const char*)(ws + WS_CQ), (const char*)(ws + WS_WUQ), (size_t)256 * 512, (size_t)256 * 512, 6, deal ? c2 * 3 : bx, deal ? 1 : G, deal ? (bx < 128 ? 0 : 3) : (384 - bx + G - 1) / G};
          pg::gemm_phase<pg::EpiUq, pg::ListSched, false, true>(lds, ws, 256, 256, Sd, E, nullptr); }
        { pg::EpiUkv E{ws + WS_KVA, (const float*)(ws + WS_SSQKV), ws + WS_VTA};
          pg::ListSched Sd{(const char*)(ws + WS_CKV), (const char*)(ws + WS_WUKV), (size_t)256 * 256, (size_t)256 * 256, 8, deal ? (bx < 128 ? bx * 3 : 384 + c2) : bx, deal ? 1 : G, deal ? (bx < 128 ? 3 : 1) : (512 - bx + G - 1) / G};
          pg::gemm_phase<pg::EpiUkv, pg::ListSched, false, true>(lds, ws, 128, 128, Sd, E, nullptr); }
    } SEAM(PH_UP);
    if (IN(PH_ATTN)) {
        int cslot = 0; constexpr int NCSLOT = 4; const int cpos = (bx >> 3) % 4;
        for (int i = 0;; ++i) {
            if (i == cpos) for (; cslot < NCSLOT; ++cslot) phase_expert_conv(args, lds, gw, NGW, lane, wave, cslot, NCSLOT);
            const long L = (long)i * G + bx; if (L >= 1024) break;
            const int b = (int)(L & 7), q = (int)(L >> 3);
#ifndef ATT_SD_A
#define ATT_SD_A 2
#endif
#ifndef ATT_SD_B
#define ATT_SD_B 2
#endif
            if (q < 64) { const int h = q >> 3, qb = q & 7; const size_t r0 = (size_t)b * S;
                at::attn_unit<192, 1536, 1024, ATT_SD_A>(ws + WS_QA + (r0 + qb * 256) * 1536 + h * 192, ws + WS_KVA + r0 * 1024 + h * 128,
                    ws + WS_KR + r0 * 64, ws + WS_VTA + (size_t)(b * 8 + h) * 32 * 8192, ws + WS_OA + (r0 + qb * 256) * 1024 + h * 128, lds); }
            else { const int h = (q - 64) >> 3, qb = q & 7, kvh = h >> 2; const size_t r0 = (size_t)b * S;
                at::attn_unit<128, 1024, 256, ATT_SD_B>(ws + WS_QG + (r0 + qb * 256) * 1024 + h * 128, ws + WS_KG + r0 * 256 + kvh * 128,
                    nullptr, ws + WS_VTG + (size_t)(b * 2 + kvh) * 32 * 8192, ws + WS_OB + (r0 + qb * 256) * 1024 + h * 128, lds); }
        }
        for (; cslot < NCSLOT; ++cslot) phase_expert_conv(args, lds, gw, NGW, lane, wave, cslot, NCSLOT);
    } SEAM(PH_ATTN);
    if (IN(PH_BR)) {
        pg::PairSched Sd; Sd.g.init(ws + WS_OA, ws + WS_WBRA, 512, 512, M, D, G, bx); Sd.A1 = (const char*)(ws + WS_OB); Sd.B1 = (const char*)(ws + WS_WBRB);
        pg::EpiBr E{ws + WS_MRG8, ws + WS_GA, ws + WS_GB};
        pg::gemm_phase<pg::EpiBr, pg::PairSched, false, true>(lds, ws, 512, 512, Sd, E, nullptr);
    } SEAM(PH_BR);
    if (IN(PH_OUT)) {
        pg::GridSched Sd; Sd.init(ws + WS_MRG8, ws + WS_WOUT, D / 2, D / 2, M, D, G, bx);
        pg::EpiOut E{args.in[0], (bf16_t*)(ws + WS_X1), (const float*)(ws + WS_MOD), (float*)(ws + WS_SSQX1)};
        pg::gemm_phase<pg::EpiOut, pg::GridSched, false, true>(lds, ws, D / 2, D / 2, Sd, E, nullptr);
    } SEAM(PH_OUT);
    if (IN(PH_ROUTER)) { phase_router(args, lds, vcu, G, lane, tid, wave); } SEAM(PH_ROUTER);
    if (IN(PH_TOPK)) { for (int p = bx; p < NPAIR; p += G) phase_topk(args, lds, p, tid, lane, wave); } SEAM(PH_TOPK);
    if (IN(PH_GATEUP)) {
        pg::MoeSched Sd{(const char*)(ws + WS_H2), (const char*)(ws + WS_WGU), (size_t)S * D, (size_t)2048 * 2048, (size_t)256 * 2048, G, bx, true};
        pg::EpiGu E{(bf16_t*)(ws + WS_ACT)};
        pg::gemm_phase<pg::EpiGu, pg::MoeSched, true, true>(lds, ws, D / 2, D / 2, Sd, E, (const int*)(ws + WS_IDX));
    } SEAM(PH_GATEUP);
    if (IN(PH_DOWN)) {
        pg::MoeSched Sd{(const char*)(ws + WS_ACT), (const char*)(ws + WS_WDN), (size_t)CAP * FF, (size_t)2048 * 1024, (size_t)256 * 1024, G, bx, false};
        pg::EpiDn E{ws + WS_Y, (const float*)(ws + WS_VAL)};
        pg::gemm_phase<pg::EpiDn, pg::MoeSched, false, true>(lds, ws, FF / 2, FF / 2, Sd, E, nullptr);
    } SEAM(PH_DOWN);
    if (IN(PH_FINAL)) { phase_final(args, gw, NGW, lane); }
#undef IN
#undef SEAM
#undef lane
}


extern "C" void kernel_launch(void* const* d_in, const int* in_sizes, int n_in, void* d_out, int out_size, void* d_ws, size_t ws_size, hipStream_t stream) {
    static int ok = 0; static int grid = 0;
    if (ok == 0) {
        if (n_in != 21 || out_size != M * D || ws_size < WS_END) { fprintf(stderr, "kernel_launch: unexpected shapes n_in %d out %d ws %zu (need %zu)\n", n_in, out_size, ws_size, (size_t)WS_END); ok = -1; return; }
        if (hipFuncSetAttribute((const void*)mega, hipFuncAttributeMaxDynamicSharedMemorySize, LDS_BYTES) != hipSuccess) { fprintf(stderr, "kernel_launch: hipFuncSetAttribute(%d B LDS) failed\n", LDS_BYTES); ok = -1; return; }
        int dev = 0, cus = 0, per_cu = 0;
        if (hipGetDevice(&dev) != hipSuccess || hipDeviceGetAttribute(&cus, hipDeviceAttributeMultiprocessorCount, dev) != hipSuccess) { ok = -1; return; }
        if (hipOccupancyMaxActiveBlocksPerMultiprocessor(&per_cu, (const void*)mega, NTHR, LDS_BYTES) != hipSuccess || per_cu < 1) { fprintf(stderr, "kernel_launch: occupancy query says %d workgroups per CU\n", per_cu); (void)hipGetLastError(); ok = -1; return; }
        grid = cus;
        ok = 1;
    }
    if (ok < 0) return;
    (void)hipMemsetAsync((unsigned char*)d_ws + WS_CTL, 0, CTL_ZERO_BYTES, stream);
    MArgs ma{}; for (int i = 0; i < 21; ++i) ma.in[i] = (const float*)d_in[i]; ma.out = (float*)d_out; ma.ws = (unsigned char*)d_ws;
    ma.ph_lo = 0; ma.ph_hi = PH_N; ma.li = 0;
    hipLaunchKernelGGL(mega, dim3(grid), dim3(NTHR), LDS_BYTES, stream, ma);
}
```
